# Optimizing an MI355X kernel written in HIP

```python
import math
import jax, jax.numpy as jnp
from jax import lax
import numpy as np

D_MODEL = 2048
BATCH = 1
SEQ = 8192
DEPTH = 4

GRID_W = 64
CTX_LEN = 256
HEAD_DIM = 128
NA_HEADS = 8
NA_WIDTH = NA_HEADS * HEAD_DIM
NA_KH_MAX = 8
NA_KW = 16
S5_WIDTH = 1024
S5_GROUP = 16
S5_GROUPS = S5_WIDTH // S5_GROUP
S5_STATE = 64
DT_MIN = 1e-3
DT_MAX = 1e-1
GQA_HEADS = 16
GQA_KV_HEADS = 4
GQA_WIDTH = GQA_HEADS * HEAD_DIM
GQA_KV_WIDTH = GQA_KV_HEADS * HEAD_DIM
ROPE_THETA = 10000.0
Q_BLOCK = 128
EVEN_IN = 4 * NA_WIDTH + 2 * S5_WIDTH
EVEN_OUT = NA_WIDTH + S5_WIDTH
ODD_IN = 2 * GQA_WIDTH + 2 * GQA_KV_WIDTH
DN_ALPHA = (2 * DEPTH) ** 0.25
DN_BETA = (8 * DEPTH) ** -0.25
LN_EPS = 1e-6
RMS_EPS = 1e-6

kernel_name = "hybrid_natten_s5_gqa_flow_backbone"


def layer_norm(x, g, b):
    xf = x.astype(jnp.float32)
    mu = jnp.mean(xf, -1, keepdims=True)
    var = jnp.mean(jnp.square(xf - mu), -1, keepdims=True)
    return ((xf - mu) * lax.rsqrt(var + LN_EPS) * g + b).astype(x.dtype)


def rms_norm(x, g):
    xf = x.astype(jnp.float32)
    return (xf * lax.rsqrt(jnp.mean(xf * xf, -1, keepdims=True) + RMS_EPS) * g).astype(x.dtype)


def ada_mod(cvec, w, b):
    m = jax.nn.silu(cvec) @ w + b
    return jnp.split(m, 3, -1)


def axial_rope(x):
    n = x.shape[1]
    t = jnp.arange(n)
    row = (t // GRID_W).astype(jnp.float32)
    col = (t % GRID_W).astype(jnp.float32)
    half = HEAD_DIM // 2
    per_axis = half // 2
    inv = ROPE_THETA ** (-jnp.arange(per_axis, dtype=jnp.float32) / per_axis)
    ang = jnp.concatenate([row[:, None] * inv, col[:, None] * inv], -1)
    cos = jnp.cos(ang)[None, :, None, :]
    sin = jnp.sin(ang)[None, :, None, :]
    xf = x.astype(jnp.float32)
    x1, x2 = xf[..., :half], xf[..., half:]
    return jnp.concatenate([x1 * cos - x2 * sin, x2 * cos + x1 * sin], -1).astype(x.dtype)


def gqa_attention(q, k, v):
    b, t, hq, dh = q.shape
    hkv = k.shape[2]
    qg = q.reshape(b, t, hkv, hq // hkv, dh)
    s = jnp.einsum('btkgd,bskd->bkgts', qg, k).astype(jnp.float32) * (dh ** -0.5)
    p = jax.nn.softmax(s, -1).astype(v.dtype)
    o = jnp.einsum('bkgts,bskd->btkgd', p, v)
    return o.reshape(b, t, hq, dh)


def neighbourhood_attention(q, k, v, qc, kc, vc, rpb, need_ctx):
    b, n, _ = q.shape
    rows = n // GRID_W
    kh = min(NA_KH_MAX, rows)
    scale = HEAD_DIM ** -0.5
    qg = q.reshape(b, rows, GRID_W, NA_HEADS, HEAD_DIM)
    kg = k.reshape(b, rows, GRID_W, NA_HEADS, HEAD_DIM)
    vg = v.reshape(b, rows, GRID_W, NA_HEADS, HEAD_DIM)
    kcx = kc.reshape(b, -1, NA_HEADS, HEAD_DIM)
    vcx = vc.reshape(b, -1, NA_HEADS, HEAD_DIM)
    r_start = jnp.clip(jnp.arange(rows) - kh // 2, 0, rows - kh)
    c_idx = jnp.arange(GRID_W)
    c_start = jnp.clip(c_idx - NA_KW // 2, 0, GRID_W - NA_KW)
    col_nb = c_start[:, None] + jnp.arange(NA_KW)
    dc = col_nb - c_idx[:, None] + NA_KW - 1
    n_loc = kh * NA_KW

    def one_row(r):
        rr = r_start[r] + jnp.arange(kh)
        k_nb = jnp.take(jnp.take(kg, rr, axis=1), col_nb, axis=2)
        v_nb = jnp.take(jnp.take(vg, rr, axis=1), col_nb, axis=2)
        dr = rr - r + NA_KH_MAX - 1
        bias = jnp.take(jnp.take(rpb, dr, axis=1), dc, axis=2)
        bias = bias.transpose(0, 2, 1, 3)
        qr = qg[:, r]
        s_loc = jnp.einsum('bwhd,bawkhd->bhwak', qr, k_nb).astype(jnp.float32) * scale + bias[None].astype(jnp.float32)
        s_ctx = jnp.einsum('bwhd,bchd->bhwc', qr, kcx).astype(jnp.float32) * scale
        s = jnp.concatenate([s_loc.reshape(b, NA_HEADS, GRID_W, n_loc), s_ctx], -1)
        p = jax.nn.softmax(s, -1).astype(v.dtype)
        p_loc = p[..., :n_loc].reshape(b, NA_HEADS, GRID_W, kh, NA_KW)
        p_ctx = p[..., n_loc:]
        return (jnp.einsum('bhwak,bawkhd->bwhd', p_loc, v_nb)
                + jnp.einsum('bhwc,bchd->bwhd', p_ctx, vcx))

    o = lax.map(one_row, jnp.arange(rows))
    o = o.transpose(1, 0, 2, 3, 4).reshape(b, n, NA_WIDTH)
    oc = None
    if need_ctx:
        qcx = qc.reshape(b, -1, NA_HEADS, HEAD_DIM)
        oc = gqa_attention(qcx, kcx, vcx).reshape(b, -1, NA_WIDTH)
    return o, oc


def s5_discretize(a_re, a_im, log_dt, b_re, b_im):
    a_re = a_re.astype(jnp.float32); a_im = a_im.astype(jnp.float32)
    b_re = b_re.astype(jnp.float32); b_im = b_im.astype(jnp.float32)
    dt = jnp.exp(log_dt.astype(jnp.float32))[..., None]
    mag = jnp.exp(a_re * dt)
    lb_re = mag * jnp.cos(a_im * dt)
    lb_im = mag * jnp.sin(a_im * dt)
    den = a_re * a_re + a_im * a_im
    n_re, n_im = lb_re - 1.0, lb_im
    f_re = (n_re * a_re + n_im * a_im) / den
    f_im = (n_im * a_re - n_re * a_im) / den
    bb_re = f_re[..., None] * b_re - f_im[..., None] * b_im
    bb_im = f_re[..., None] * b_im + f_im[..., None] * b_re
    return lb_re, lb_im, bb_re, bb_im


def complex_linear_scan(a_re, a_im, b_re, b_im, reverse):
    ar = jnp.broadcast_to(a_re, b_re.shape)
    ai = jnp.broadcast_to(a_im, b_re.shape)

    def combine(e1, e2):
        a1r, a1i, b1r, b1i = e1
        a2r, a2i, b2r, b2i = e2
        return (a1r * a2r - a1i * a2i, a1r * a2i + a1i * a2r,
                a2r * b1r - a2i * b1i + b2r, a2r * b1i + a2i * b1r + b2i)

    _, _, hr, hi = lax.associative_scan(combine, (ar, ai, b_re, b_im), reverse=reverse, axis=1)
    return hr, hi


def s5_bidirectional(u, uc, a_re, a_im, log_dt, b_re, b_im, c_re, c_im, d, need_ctx):
    lb_re, lb_im, bb_re, bb_im = s5_discretize(a_re, a_im, log_dt, b_re, b_im)
    c_re = c_re.astype(jnp.float32); c_im = c_im.astype(jnp.float32)
    df = d.astype(jnp.float32)
    uf = u.astype(jnp.float32)
    ucf = uc.astype(jnp.float32)

    def drive(z, k):
        zg = z.reshape(z.shape[0], z.shape[1], S5_GROUPS, S5_GROUP)
        return (jnp.einsum('blgc,gpc->blgp', zg, bb_re[k]),
                jnp.einsum('blgc,gpc->blgp', zg, bb_im[k]))

    def readout(hr, hi, k):
        y = jnp.einsum('blgp,gcp->blgc', hr, c_re[k]) - jnp.einsum('blgp,gcp->blgc', hi, c_im[k])
        return y.reshape(y.shape[0], y.shape[1], S5_WIDTH)

    y = uf * df
    yc = ucf * df
    for k, rev in ((0, False), (1, True)):
        brc, bic = drive(ucf, k)
        hrc, hic = complex_linear_scan(lb_re[k], lb_im[k], brc, bic, rev)
        end = 0 if rev else -1
        h0r, h0i = hrc[:, end], hic[:, end]
        br, bi = drive(uf, k)
        start = -1 if rev else 0
        br = br.at[:, start].add(lb_re[k] * h0r - lb_im[k] * h0i)
        bi = bi.at[:, start].add(lb_re[k] * h0i + lb_im[k] * h0r)
        hr, hi = complex_linear_scan(lb_re[k], lb_im[k], br, bi, rev)
        y = y + readout(hr, hi, k)
        if need_ctx:
            yc = yc + readout(hrc, hic, k)
    return y.astype(u.dtype), (yc.astype(uc.dtype) if need_ctx else None)


def even_layer(h, hc, w_in, w_out, rpb, a_re, a_im, log_dt, b_re, b_im, c_re, c_im, d, glu_w, glu_b, need_ctx):
    splits = [NA_WIDTH, 2 * NA_WIDTH, 3 * NA_WIDTH, 4 * NA_WIDTH, 4 * NA_WIDTH + S5_WIDTH]
    qa, ka, va, ga, ub, gb = jnp.split(h @ w_in, splits, -1)
    qac, kac, vac, gac, ubc, gbc = jnp.split(hc @ w_in, splits, -1)
    ya, yac = neighbourhood_attention(qa, ka, va, qac, kac, vac, rpb, need_ctx)
    yb, ybc = s5_bidirectional(ub, ubc, a_re, a_im, log_dt, b_re, b_im, c_re, c_im, d, need_ctx)

    def merge(za, zb, g_a, g_b):
        zb = jax.nn.gelu(zb)
        zb = zb * jax.nn.sigmoid(zb @ glu_w + glu_b)
        return jnp.concatenate([za * jax.nn.silu(g_a), zb * jax.nn.silu(g_b)], -1) @ w_out

    y = merge(ya, yb, ga, gb)
    yc = merge(yac, ybc, gac, gbc) if need_ctx else None
    return y, yc


def odd_layer(h, hc, w_in, w_out, q_g, k_g, need_ctx):
    b, n, _ = h.shape
    splits = [GQA_WIDTH, GQA_WIDTH + GQA_KV_WIDTH, GQA_WIDTH + 2 * GQA_KV_WIDTH]

    def project(z):
        bb, t, _ = z.shape
        q, k, v, g = jnp.split(z @ w_in, splits, -1)
        q = rms_norm(q.reshape(bb, t, GQA_HEADS, HEAD_DIM), q_g)
        k = rms_norm(k.reshape(bb, t, GQA_KV_HEADS, HEAD_DIM), k_g)
        v = v.reshape(bb, t, GQA_KV_HEADS, HEAD_DIM)
        return q, k, v, g

    q, k, v, g = project(h)
    qc, kc, vc, gc = project(hc)
    q = axial_rope(q)
    k = axial_rope(k)
    k_all = jnp.concatenate([k, kc], 1)
    v_all = jnp.concatenate([v, vc], 1)
    qb = q.reshape(b, n // Q_BLOCK, Q_BLOCK, GQA_HEADS, HEAD_DIM).transpose(1, 0, 2, 3, 4)
    o = lax.map(lambda qq: gqa_attention(qq, k_all, v_all), qb)
    o = o.transpose(1, 0, 2, 3, 4).reshape(b, n, GQA_WIDTH)
    y = (o * jax.nn.silu(g)) @ w_out
    yc = None
    if need_ctx:
        oc = gqa_attention(qc, kc, vc).reshape(b, hc.shape[1], GQA_WIDTH)
        yc = (oc * jax.nn.silu(gc)) @ w_out
    return y, yc


def setup_inputs(seed: int = 0) -> dict:
    key = jax.random.key(seed)
    ne = (DEPTH + 1) // 2
    no = DEPTH // 2
    f32 = jnp.float32

    def nrm(i, shape, s):
        return jax.random.normal(jax.random.fold_in(key, i), shape, f32) * s

    even_col = jnp.ones((EVEN_IN,), f32).at[2 * NA_WIDTH:3 * NA_WIDTH].set(DN_BETA)
    odd_col = jnp.ones((ODD_IN,), f32).at[GQA_WIDTH + GQA_KV_WIDTH:GQA_WIDTH + 2 * GQA_KV_WIDTH].set(DN_BETA)
    a_im0 = math.pi * jnp.arange(S5_STATE, dtype=f32)
    return {
        "x": nrm(0, (BATCH, SEQ, D_MODEL), 1.0),
        "c": nrm(1, (BATCH, D_MODEL), 1.0),
        "ctx": nrm(2, (BATCH, CTX_LEN, D_MODEL), 1.0),
        "c_ctx": nrm(3, (D_MODEL,), 1.0),
        "ada_w": nrm(4, (DEPTH, D_MODEL, 3 * D_MODEL), 0.5 * D_MODEL ** -0.5),
        "ada_b": nrm(5, (DEPTH, 3 * D_MODEL), 0.02),
        "ln_g": 1.0 + nrm(6, (DEPTH, D_MODEL), 0.02),
        "ln_b": nrm(7, (DEPTH, D_MODEL), 0.02),
        "ev_w_in": nrm(8, (ne, D_MODEL, EVEN_IN), D_MODEL ** -0.5) * even_col,
        "ev_w_out": nrm(9, (ne, EVEN_OUT, D_MODEL), DN_BETA * EVEN_OUT ** -0.5),
        "na_rpb": nrm(10, (ne, NA_HEADS, 2 * NA_KH_MAX - 1, 2 * NA_KW - 1), 0.02),
        "s5_a_re": -0.5 + nrm(11, (ne, 2, S5_GROUPS, S5_STATE), 0.01),
        "s5_a_im": a_im0 + nrm(12, (ne, 2, S5_GROUPS, S5_STATE), 0.01),
        "s5_log_dt": jax.random.uniform(jax.random.fold_in(key, 13), (ne, 2, S5_GROUPS), f32,
                                        minval=math.log(DT_MIN), maxval=math.log(DT_MAX)),
        "s5_b_re": nrm(14, (ne, 2, S5_GROUPS, S5_STATE, S5_GROUP), (2 * S5_GROUP) ** -0.5),
        "s5_b_im": nrm(15, (ne, 2, S5_GROUPS, S5_STATE, S5_GROUP), (2 * S5_GROUP) ** -0.5),
        "s5_c_re": nrm(16, (ne, 2, S5_GROUPS, S5_GROUP, S5_STATE), (2 * S5_STATE) ** -0.5),
        "s5_c_im": nrm(17, (ne, 2, S5_GROUPS, S5_GROUP, S5_STATE), (2 * S5_STATE) ** -0.5),
        "s5_d": nrm(18, (ne, S5_WIDTH), 1.0),
        "s5_glu_w": nrm(19, (ne, S5_WIDTH, S5_WIDTH), S5_WIDTH ** -0.5),
        "s5_glu_b": nrm(20, (ne, S5_WIDTH), 0.02),
        "od_w_in": nrm(21, (no, D_MODEL, ODD_IN), D_MODEL ** -0.5) * odd_col,
        "od_w_out": nrm(22, (no, GQA_WIDTH, D_MODEL), DN_BETA * GQA_WIDTH ** -0.5),
        "q_norm_g": 1.0 + nrm(23, (no, HEAD_DIM), 0.02),
        "k_norm_g": 1.0 + nrm(24, (no, HEAD_DIM), 0.02),
    }


def reference(x, c, ctx, c_ctx, ada_w, ada_b, ln_g, ln_b, ev_w_in, ev_w_out, na_rpb,
              s5_a_re, s5_a_im, s5_log_dt, s5_b_re, s5_b_im, s5_c_re, s5_c_im, s5_d,
              s5_glu_w, s5_glu_b, od_w_in, od_w_out, q_norm_g, k_norm_g):
    xc = ctx
    for l in range(DEPTH):
        need_ctx = l < DEPTH - 1
        sh, sc, gt = ada_mod(c, ada_w[l], ada_b[l])
        shc, scc, gtc = ada_mod(c_ctx, ada_w[l], ada_b[l])
        h = x * (1.0 + sc[:, None, :]) + sh[:, None, :]
        hc = xc * (1.0 + scc) + shc
        if l % 2 == 0:
            i = l // 2
            y, yc = even_layer(h, hc, ev_w_in[i], ev_w_out[i], na_rpb[i],
                               s5_a_re[i], s5_a_im[i], s5_log_dt[i], s5_b_re[i], s5_b_im[i],
                               s5_c_re[i], s5_c_im[i], s5_d[i], s5_glu_w[i], s5_glu_b[i], need_ctx)
        else:
            i = l // 2
            y, yc = odd_layer(h, hc, od_w_in[i], od_w_out[i], q_norm_g[i], k_norm_g[i], need_ctx)
        x = layer_norm(DN_ALPHA * x + gt[:, None, :] * y, ln_g[l], ln_b[l])
        if need_ctx:
            xc = layer_norm(DN_ALPHA * xc + gtc * yc, ln_g[l], ln_b[l])
    return x
```

```cpp
#include <hip/hip_runtime.h>
#include <hip/hip_cooperative_groups.h>
#include <cstdio>
#include <cstdint>
namespace cg = cooperative_groups;

#define LAS __attribute__((address_space(3)))
typedef unsigned short bf16_t;
typedef short bf16x8 __attribute__((ext_vector_type(8)));
typedef short s16x4 __attribute__((ext_vector_type(4)));
typedef float f32x4 __attribute__((ext_vector_type(4)));
typedef float f32x16 __attribute__((ext_vector_type(16)));
typedef unsigned u32x4 __attribute__((ext_vector_type(4)));
typedef unsigned u32x2 __attribute__((ext_vector_type(2)));

__device__ __forceinline__ unsigned cvt_pk_bf16(float lo, float hi) { unsigned r; asm volatile("v_cvt_pk_bf16_f32 %0, %1, %2" : "=v"(r) : "v"(lo), "v"(hi)); return r; }
__device__ __forceinline__ float bf_lo(unsigned w) { return __uint_as_float(w << 16); }
__device__ __forceinline__ float bf_hi(unsigned w) { return __uint_as_float(w & 0xffff0000u); }
__device__ __forceinline__ float bf2f(bf16_t b) { return __uint_as_float((unsigned)b << 16); }
__device__ __forceinline__ bf16_t f2bf(float f) { return (bf16_t)(cvt_pk_bf16(f, 0.f) & 0xffffu); }
__device__ __forceinline__ unsigned pack4_fp8(f32x4 h) { int w = __builtin_amdgcn_cvt_pk_fp8_f32(h[0], h[1], 0, false); w = __builtin_amdgcn_cvt_pk_fp8_f32(h[2], h[3], w, true); return (unsigned)w; }
__device__ __forceinline__ unsigned pack4_fp8_sat(f32x4 h) {
    h[0] = __builtin_amdgcn_fmed3f(h[0], -448.f, 448.f); h[1] = __builtin_amdgcn_fmed3f(h[1], -448.f, 448.f); h[2] = __builtin_amdgcn_fmed3f(h[2], -448.f, 448.f); h[3] = __builtin_amdgcn_fmed3f(h[3], -448.f, 448.f);
    return pack4_fp8(h); }
__device__ __forceinline__ float sigmoidf_(float v) { return __builtin_amdgcn_rcpf(1.f + __expf(-v)); }
__device__ __forceinline__ float siluf_(float v) { return v * sigmoidf_(v); }
__device__ __forceinline__ float gelu_tanh(float v) { const float z = 0.7978845608028654f * (v + 0.044715f * v * v * v); return v * sigmoidf_(2.f * z); }
__device__ __forceinline__ float wave_sum(float v) {
#pragma unroll
    for (int o = 1; o < 64; o <<= 1) v += __shfl_xor(v, o);
    return v;
}

__device__ __forceinline__ int ltid() { int t = threadIdx.x; asm volatile("" : "+v"(t)); return t; }
__device__ __forceinline__ int lbid() { int b = blockIdx.x; asm volatile("" : "+s"(b)); return b; }
__device__ __forceinline__ unsigned char* lws(unsigned char* w) { asm volatile("" : "+s"(w)); return w; }

constexpr int DM = 2048, SEQ = 8192, CTXL = 256, MROWS = SEQ + CTXL;
constexpr int EVEN_IN = 6144, ODD_IN = 5120;
constexpr int LDE = EVEN_IN + 128, LDO = ODD_IN + 128;
constexpr float DN_ALPHA = 1.6817928305074290f;
constexpr float LN_EPS = 1e-6f, RMS_EPS = 1e-6f;
constexpr float OG_SCALE = 4.f, WIN_SCALE = 32.f, WOUT_SCALE = 64.f;
constexpr int NCHUNK = MROWS / 16;

namespace pg8 {
#define PG8_LAS __attribute__((address_space(3)))
typedef unsigned short bf16_t;
typedef short bf16x8 __attribute__((ext_vector_type(8)));
typedef float f32x4 __attribute__((ext_vector_type(4)));
typedef unsigned u32x4 __attribute__((ext_vector_type(4)));
constexpr int BM = 256, BK = 64, HALF = 128, HTB = HALF * BK * 2  , STAGE_BYTES = 8 * HTB, NXCD = 8, WGM = 8;

__host__ __device__ __forceinline__ int lds_byte(int r, int c) { const int st = (r >> 4) * 2 + (c >> 5), rr = r & 15, cc = c & 31, ob = rr * 64 + cc * 2; return st * 1024 + (ob ^ (((ob >> 9) & 1) << 5)); }
__host__ __device__ __forceinline__ void stage_rc(int b, int& R, int& C) { const int st = b / 1024, sb = b % 1024, swz = sb ^ (((sb >> 9) & 1) << 5); R = (st >> 1) * 16 + swz / 64; C = (st & 1) * 32 + (swz % 64) / 2; }
__host__ __device__ __forceinline__ int perm32(int rho) { const int n = rho >> 4, i = rho & 15; return 8 * (i >> 2) + 4 * n + (i & 3); }

struct Unit { int pm, pn; };
struct Gemm { const bf16_t* A; const bf16_t* Bt; int M, N, K, ld; };

struct StaticOrder {
    int nM, nN, nwg, G, c;
    __host__ __device__ void init(int M, int N, int G_, int c_) { nM = M / BM; nN = N / BM; nwg = nM * nN; G = G_; c = c_; }
    __host__ __device__ bool next(int i, Unit& u) const {
        const long L = (long)i * G + c; if (L >= nwg) return false;
        int wgid = (int)L; { const int q = nwg / NXCD, r = nwg % NXCD, xcd = wgid % NXCD, off = wgid / NXCD; wgid = (xcd < r ? xcd * (q + 1) : r * (q + 1) + (xcd - r) * q) + off; }
        const int nig = WGM * nN, gid = wgid / nig, fm = gid * WGM, gsz = (nM - fm) < WGM ? (nM - fm) : WGM;
        u.pm = fm + ((wgid % nig) % gsz); u.pn = (wgid % nig) / gsz; return true;
    }
    __device__ __forceinline__ void a_ready(const Unit&) const {}
    __device__ __forceinline__ void done(const Unit&) const {}
};

struct EpiBf16 {
    static constexpr bool PERM = true, AFTER_DRAIN = false;
    bf16_t* O; int ldc; float sc;
    __device__ __forceinline__ void operator()(const f32x4 (&acc)[2][2][4][2], const Unit& u, int wr, int wc, int fr, int fq) const {
        asm volatile("" : "+v"(fr), "+v"(fq));
        const int row0 = u.pm * BM + wr * 64 + fr; const int col0 = u.pn * BM + wc * 32 + 8 * fq;
#pragma unroll
        for (int ai = 0; ai < 2; ++ai)
#pragma unroll
            for (int m = 0; m < 4; ++m) { bf16_t* rowp = O + (size_t)(row0 + ai * HALF + m * 16) * ldc + col0;
#pragma unroll
                for (int bj = 0; bj < 2; ++bj) { const f32x4 v0 = acc[ai][bj][m][0] * sc, v1 = acc[ai][bj][m][1] * sc;
                    u32x4 w; w.x = ::cvt_pk_bf16(v0[0], v0[1]); w.y = ::cvt_pk_bf16(v0[2], v0[3]); w.z = ::cvt_pk_bf16(v1[0], v1[1]); w.w = ::cvt_pk_bf16(v1[2], v1[3]);
                    *(u32x4*)(rowp + bj * HALF) = w; } }
    }
};
struct EpiGlu {
    static constexpr bool PERM = true, AFTER_DRAIN = false;
    const bf16_t* ZB; const bf16_t* P; const float* bias; bf16_t* OG;
    __device__ __forceinline__ void operator()(const f32x4 (&acc)[2][2][4][2], const Unit& u, int wr, int wc, int fr, int fq) const {
        asm volatile("" : "+v"(fr), "+v"(fq));
        const int row0 = u.pm * BM + wr * 64 + fr; const int col0 = u.pn * BM + wc * 32 + 8 * fq;
        f32x4 bv[2][2];
#pragma unroll
        for (int bj = 0; bj < 2; ++bj)
#pragma unroll
            for (int n = 0; n < 2; ++n) bv[bj][n] = *(const f32x4*)(bias + col0 + bj * HALF + 4 * n);
#pragma unroll
        for (int ai = 0; ai < 2; ++ai)
#pragma unroll
            for (int m = 0; m < 4; ++m) { const size_t row = (size_t)(row0 + ai * HALF + m * 16);
#pragma unroll
                for (int bj = 0; bj < 2; ++bj) { const int col = col0 + bj * HALF;
                    const u32x4 zw = *(const u32x4*)(ZB + row * 1024 + col); const u32x4 gw = *(const u32x4*)(P + row * LDE + 5120 + col);
                    const f32x4 v0 = acc[ai][bj][m][0] + bv[bj][0], v1 = acc[ai][bj][m][1] + bv[bj][1];
                    float o[8];
#pragma unroll
                    for (int e = 0; e < 4; ++e) { const unsigned z = zw[e], g = gw[e]; const float a0 = e < 2 ? v0[2 * e] : v1[2 * e - 4], a1 = e < 2 ? v0[2 * e + 1] : v1[2 * e - 3];
                        o[2 * e] = ::bf_lo(z) * ::sigmoidf_(a0) * ::siluf_(::bf_lo(g)); o[2 * e + 1] = ::bf_hi(z) * ::sigmoidf_(a1) * ::siluf_(::bf_hi(g)); }
                    u32x2 w; w.x = ::pack4_fp8_sat((f32x4){o[0], o[1], o[2], o[3]} * OG_SCALE); w.y = ::pack4_fp8_sat((f32x4){o[4], o[5], o[6], o[7]} * OG_SCALE);
                    *(u32x2*)((unsigned char*)OG + row * 2048 + 1024 + col) = w; } }
    }
};
struct EpiOut {
    static constexpr bool PERM = true, AFTER_DRAIN = false;
    const float* srcL; const float* srcC; float* X; const float* gtL; const float* gtC; float alpha, sc;
    __device__ __forceinline__ void operator()(const f32x4 (&acc)[2][2][4][2], const Unit& u, int wr, int wc, int fr, int fq) const {
        asm volatile("" : "+v"(fr), "+v"(fq));
        const int row0 = u.pm * BM + wr * 64 + fr; const int col0 = u.pn * BM + wc * 32 + 8 * fq;
        const float* src = u.pm < 32 ? srcL : srcC; const float* gt = u.pm < 32 ? gtL : gtC;
        f32x4 gv[2][2];
#pragma unroll
        for (int bj = 0; bj < 2; ++bj)
#pragma unroll
            for (int n = 0; n < 2; ++n) gv[bj][n] = *(const f32x4*)(gt + col0 + bj * HALF + 4 * n) * sc;
#pragma unroll
        for (int ai = 0; ai < 2; ++ai)
#pragma unroll
            for (int m = 0; m < 4; ++m) { const size_t off = (size_t)(row0 + ai * HALF + m * 16) * 2048 + col0;
#pragma unroll
                for (int bj = 0; bj < 2; ++bj)
#pragma unroll
                    for (int n = 0; n < 2; ++n) { const f32x4 xs = *(const f32x4*)(src + off + bj * HALF + 4 * n);
                        *(f32x4*)(X + off + bj * HALF + 4 * n) = xs * alpha + gv[bj][n] * acc[ai][bj][m][n]; } }
    }
};

struct EpiPart {
    static constexpr bool PERM = true, AFTER_DRAIN = false;
    float* O; float sc;
    __device__ __forceinline__ void operator()(const f32x4 (&acc)[2][2][4][2], const Unit& u, int wr, int wc, int fr, int fq) const {
        asm volatile("" : "+v"(fr), "+v"(fq));
        const int row0 = u.pm * BM + wr * 64 + fr; const int col0 = u.pn * BM + wc * 32 + 8 * fq;
#pragma unroll
        for (int ai = 0; ai < 2; ++ai)
#pragma unroll
            for (int m = 0; m < 4; ++m) { const size_t off = (size_t)(row0 + ai * HALF + m * 16) * 2048 + col0;
#pragma unroll
                for (int bj = 0; bj < 2; ++bj)
#pragma unroll
                    for (int n = 0; n < 2; ++n) *(f32x4*)(O + off + bj * HALF + 4 * n) = acc[ai][bj][m][n] * sc; }
    }
};
struct OneUnit { int pn; bool valid;
    __device__ __forceinline__ bool next(int i, Unit& u) const { u.pm = 0; u.pn = pn; return i == 0 && valid; }
    __device__ __forceinline__ void a_ready(const Unit&) const {}
    __device__ __forceinline__ void done(const Unit&) const {}
};

template <class Epi, class Sched, bool ALIGN_EPI = false, bool SP2 = false, bool FP8 = false>
__device__ __forceinline__ void gemm_phase(PG8_LAS unsigned char* lds, const Gemm g, const Sched& S, const Epi& E) {
    const int tid = ltid(), wid = __builtin_amdgcn_readfirstlane(tid >> 6), lane = tid & 63, wr = wid >> 2, wc = wid & 3, fr = lane & 15, fq = lane >> 4;
    const int K = g.K, nt = K / BK;
    unsigned voffA[2], voffB[2];
#pragma unroll
    for (int i = 0; i < 2; ++i) { int R, C; stage_rc(tid * 16 + i * 8192, R, C); const int Rb = Epi::PERM ? ((R & ~31) + perm32(R & 31)) : R;
        voffA[i] = (unsigned)(R * g.ld + C) * 2u; voffB[i] = (unsigned)(Rb * g.ld + C) * 2u; }
    const size_t kstep = (size_t)(BK * 2);
    const size_t hstep = (size_t)HALF * g.ld * 2;
    const size_t tstep = 2 * hstep;
    const unsigned ldsw = (unsigned)wid * 1024u;
    const int aoff = lds_byte(wr * 64 + fr, fq * 8), boff = lds_byte(wc * 32 + fr, fq * 8);
#define PG8_SA(b, h) (((b) * 2 + (h)) * HTB)
#define PG8_SB(b, h) ((4 + (b) * 2 + (h)) * HTB)
#define PG8_STAGE(bufoff, gbase, voff) do { _Pragma("unroll") for (int _i = 0; _i < 2; ++_i) \
        __builtin_amdgcn_global_load_lds((const unsigned*)((const char*)(gbase) + (voff)[_i]), (PG8_LAS unsigned*)(lds + (bufoff) + ldsw + _i * 8192), 16, 0, 0); } while (0)
#define PG8_LDA(dst, b, h) do { if constexpr (FP8) { _Pragma("unroll") for (int m = 0; m < 4; ++m) dst##8[m] = __builtin_shufflevector(*(const PG8_LAS i32x4_*)(lds + PG8_SA(b, h) + aoff + m * 2048), *(const PG8_LAS i32x4_*)(lds + PG8_SA(b, h) + aoff + m * 2048 + 1024), 0, 1, 2, 3, 4, 5, 6, 7); } \
        else { _Pragma("unroll") for (int m = 0; m < 4; ++m) _Pragma("unroll") for (int k = 0; k < 2; ++k) dst[m][k] = *(const PG8_LAS bf16x8*)(lds + PG8_SA(b, h) + aoff + m * 2048 + k * 1024); } } while (0)
#define PG8_LDB(dst, b, h) do { if constexpr (FP8) { _Pragma("unroll") for (int n = 0; n < 2; ++n) dst##8[n] = __builtin_shufflevector(*(const PG8_LAS i32x4_*)(lds + PG8_SB(b, h) + boff + n * 2048), *(const PG8_LAS i32x4_*)(lds + PG8_SB(b, h) + boff + n * 2048 + 1024), 0, 1, 2, 3, 4, 5, 6, 7); } \
        else { _Pragma("unroll") for (int n = 0; n < 2; ++n) _Pragma("unroll") for (int k = 0; k < 2; ++k) dst[n][k] = *(const PG8_LAS bf16x8*)(lds + PG8_SB(b, h) + boff + n * 2048 + k * 1024); } } while (0)
#define PG8_MMA(ai, bj, At, Bt) do { __builtin_amdgcn_s_setprio(1); _Pragma("unroll") for (int m = 0; m < 4; ++m) _Pragma("unroll") for (int n = 0; n < 2; ++n) { \
        if constexpr (FP8) asm volatile("v_mfma_scale_f32_16x16x128_f8f6f4 %0, %1, %2, %0, %3, %3 op_sel_hi:[0,0,0]" : "+v"(acc[ai][bj][m][n]) : "v"(Bt##8[n]), "v"(At##8[m]), "v"(one_scale)); \
        else { _Pragma("unroll") for (int k = 0; k < 2; ++k) acc[ai][bj][m][n] = __builtin_amdgcn_mfma_f32_16x16x32_bf16(Bt[n][k], At[m][k], acc[ai][bj][m][n], 0, 0, 0); } } \
        __builtin_amdgcn_s_setprio(0); } while (0)
#define PG8_WAIT_V(n) asm volatile("s_waitcnt vmcnt(" #n ")" ::: "memory")
#define PG8_WAIT_L(n) asm volatile("s_waitcnt lgkmcnt(" #n ")" ::: "memory")
#define PG8_BAR __builtin_amdgcn_s_barrier()
#define PG8_SCHED __builtin_amdgcn_sched_barrier(0)
    Unit cur, nxt; int ui = 0;
    if (!S.next(0, cur)) return;
    f32x4 acc[2][2][4][2];
#pragma unroll
    for (int a = 0; a < 2; ++a)
#pragma unroll
        for (int b = 0; b < 2; ++b)
#pragma unroll
            for (int m = 0; m < 4; ++m)
#pragma unroll
                for (int n = 0; n < 2; ++n) acc[a][b][m][n] = (f32x4){0.f, 0.f, 0.f, 0.f};
    typedef int i32x4_ __attribute__((ext_vector_type(4))); typedef int i32x8_ __attribute__((ext_vector_type(8)));
    bf16x8 At[4][2], B0[2][2], B1[2][2]; i32x8_ At8[4], B08[2], B18[2]; const int one_scale = 0x7F7F7F7F;
    const char* cA = (const char*)g.A + (size_t)cur.pm * tstep; const char* cB = (const char*)g.Bt + (size_t)cur.pn * tstep;
    S.a_ready(cur);
    if constexpr (SP2) {
        PG8_STAGE(PG8_SB(0, 0), cB, voffB); PG8_STAGE(PG8_SB(0, 1), cB + hstep, voffB); PG8_STAGE(PG8_SA(0, 0), cA, voffA); PG8_STAGE(PG8_SA(0, 1), cA + hstep, voffA);
        if (wr == 1) PG8_BAR;
        PG8_WAIT_V(2); PG8_BAR;
        PG8_STAGE(PG8_SB(1, 0), cB + kstep, voffB); PG8_STAGE(PG8_SA(1, 0), cA + kstep, voffA); PG8_STAGE(PG8_SB(1, 1), cB + hstep + kstep, voffB);
        PG8_WAIT_V(6); PG8_BAR;
    } else {
        PG8_STAGE(PG8_SB(0, 0), cB, voffB); PG8_STAGE(PG8_SA(0, 0), cA, voffA); PG8_STAGE(PG8_SB(0, 1), cB + hstep, voffB); PG8_STAGE(PG8_SA(0, 1), cA + hstep, voffA);
        if (wr == 1) PG8_BAR;
        PG8_WAIT_V(4); PG8_BAR;
        PG8_STAGE(PG8_SB(1, 0), cB + kstep, voffB); PG8_STAGE(PG8_SA(1, 0), cA + kstep, voffA); PG8_STAGE(PG8_SB(1, 1), cB + hstep + kstep, voffB);
        PG8_WAIT_V(6); PG8_BAR;
    }
    for (;;) {
        const bool has_next = S.next(ui + 1, nxt);
        const char* nA = has_next ? (const char*)g.A + (size_t)nxt.pm * tstep : cA; const char* nB = has_next ? (const char*)g.Bt + (size_t)nxt.pn * tstep : cB;
        for (int t = 0; t < nt; t += 2) {
            const bool last = (t == nt - 2);
            const char* a1 = cA + (size_t)(t + 1) * kstep;
            const char* a2 = last ? nA : cA + (size_t)(t + 2) * kstep; const char* b2 = last ? nB : cB + (size_t)(t + 2) * kstep;
            const char* a3 = a2 + kstep; const char* b3 = b2 + kstep;
            if (last && has_next) S.a_ready(nxt);
            if constexpr (SP2) {
            PG8_LDB(B0, 0, 0); PG8_LDB(B1, 0, 1); PG8_SCHED; PG8_LDA(At, 0, 0); PG8_STAGE(PG8_SA(1, 1), a1 + hstep, voffA);
            PG8_WAIT_V(8); PG8_WAIT_L(0); PG8_BAR; PG8_MMA(0, 0, At, B0); PG8_MMA(0, 1, At, B1); PG8_BAR; PG8_SCHED;
            PG8_LDA(At, 0, 1); PG8_STAGE(PG8_SB(0, 0), b2, voffB); PG8_STAGE(PG8_SB(0, 1), b2 + hstep, voffB); PG8_STAGE(PG8_SA(0, 0), a2, voffA);
            PG8_WAIT_V(8); PG8_WAIT_L(0); PG8_BAR; PG8_MMA(1, 0, At, B0); PG8_MMA(1, 1, At, B1); PG8_BAR; PG8_SCHED;
            PG8_LDB(B0, 1, 0); PG8_LDB(B1, 1, 1); PG8_SCHED; PG8_LDA(At, 1, 0); PG8_STAGE(PG8_SA(0, 1), a2 + hstep, voffA);
            PG8_WAIT_V(8); PG8_WAIT_L(0); PG8_BAR; PG8_MMA(0, 0, At, B0); PG8_MMA(0, 1, At, B1); PG8_BAR; PG8_SCHED;
            PG8_LDA(At, 1, 1); PG8_STAGE(PG8_SB(1, 0), b3, voffB); PG8_STAGE(PG8_SB(1, 1), b3 + hstep, voffB); PG8_STAGE(PG8_SA(1, 0), a3, voffA);
            PG8_WAIT_V(8); PG8_WAIT_L(0); PG8_BAR; PG8_MMA(1, 0, At, B0); PG8_MMA(1, 1, At, B1); PG8_BAR; PG8_SCHED;
            } else {
            PG8_LDB(B0, 0, 0); PG8_SCHED; PG8_LDA(At, 0, 0); PG8_STAGE(PG8_SA(1, 1), a1 + hstep, voffA);
            PG8_WAIT_L(8); PG8_BAR; PG8_WAIT_L(0); PG8_MMA(0, 0, At, B0); PG8_BAR; PG8_SCHED;
            PG8_LDB(B1, 0, 1); PG8_STAGE(PG8_SB(0, 0), b2, voffB);
            PG8_BAR; PG8_WAIT_L(0); PG8_MMA(0, 1, At, B1); PG8_BAR;
            PG8_LDA(At, 0, 1); PG8_STAGE(PG8_SA(0, 0), a2, voffA);
            PG8_BAR; PG8_WAIT_L(0); PG8_MMA(1, 0, At, B0); PG8_BAR; PG8_SCHED;
            PG8_STAGE(PG8_SB(0, 1), b2 + hstep, voffB);
            PG8_WAIT_V(6); PG8_BAR; PG8_MMA(1, 1, At, B1); PG8_BAR;
            PG8_LDB(B0, 1, 0); PG8_SCHED; PG8_LDA(At, 1, 0); PG8_STAGE(PG8_SA(0, 1), a2 + hstep, voffA);
            PG8_WAIT_L(8); PG8_BAR; PG8_WAIT_L(0); PG8_MMA(0, 0, At, B0); PG8_BAR; PG8_SCHED;
            PG8_LDB(B1, 1, 1); PG8_STAGE(PG8_SB(1, 0), b3, voffB);
            PG8_BAR; PG8_WAIT_L(0); PG8_MMA(0, 1, At, B1); PG8_BAR;
            PG8_LDA(At, 1, 1); PG8_STAGE(PG8_SA(1, 0), a3, voffA);
            PG8_BAR; PG8_WAIT_L(0); PG8_MMA(1, 0, At, B0); PG8_BAR; PG8_SCHED;
            PG8_STAGE(PG8_SB(1, 1), b3 + hstep, voffB);
            PG8_WAIT_V(6); PG8_BAR; PG8_MMA(1, 1, At, B1); PG8_BAR;
            }
        }
        if constexpr (ALIGN_EPI) { if (wr == 0) PG8_BAR; }
        if constexpr (!Epi::AFTER_DRAIN) { E(acc, cur, wr, wc, fr, fq); S.done(cur); }
        if (!has_next) break;
#pragma unroll
        for (int a = 0; a < 2; ++a)
#pragma unroll
            for (int b = 0; b < 2; ++b)
#pragma unroll
                for (int m = 0; m < 4; ++m)
#pragma unroll
                    for (int n = 0; n < 2; ++n) acc[a][b][m][n] = (f32x4){0.f, 0.f, 0.f, 0.f};
        cur = nxt; cA = nA; cB = nB; ++ui;
        if constexpr (ALIGN_EPI) { if (wr == 1) PG8_BAR; }
    }
    PG8_WAIT_V(0);
    if constexpr (!ALIGN_EPI) { if (wr == 0) PG8_BAR; }
    PG8_BAR;
    if constexpr (Epi::AFTER_DRAIN) { E.fused(acc, cur, wr, wc, fr, fq, lds, wid, lane); S.done(cur); }
#undef PG8_SA
#undef PG8_SB
#undef PG8_STAGE
#undef PG8_LDA
#undef PG8_LDB
#undef PG8_MMA
#undef PG8_WAIT_V
#undef PG8_WAIT_L
#undef PG8_BAR
#undef PG8_SCHED
}
}
namespace att {
using bf16 = unsigned short;
constexpr int   D = 128, NW = 8, QBLK = 32, KVBLK = 64;
constexpr float SCALE = 0.088388347648318440f;
#ifndef ATT_THR
#define ATT_THR 8.f
#endif
constexpr float THR = ATT_THR;
#ifndef ATT_SDEPTH
#define ATT_SDEPTH 1
#endif
constexpr int SDEPTH = ATT_SDEPTH;
constexpr size_t SHM_V = KVBLK * D * 2, SHM_K = KVBLK * D * 2, SHM_ATTN = 2 * SHM_V + 2 * SHM_K + NW * 64 * 4;
using bf16x8 = __attribute__((ext_vector_type(8))) short;
using s16x4  = __attribute__((ext_vector_type(4))) short;
using f32x16 = __attribute__((ext_vector_type(16))) float;
using f32x8  = __attribute__((ext_vector_type(8))) float;
using u32x4  = __attribute__((ext_vector_type(4))) unsigned;
#define KSWZ(row, colB) ((row) * 256 + ((colB) ^ (((row) & 7) << 4)))
#define SBAR() __builtin_amdgcn_sched_barrier(0)
__device__ __forceinline__ int crow(int r, int hi) { return (r & 3) + 8 * (r >> 2) + 4 * hi; }
__device__ __forceinline__ unsigned cvtpk(float lo, float hi) {
  unsigned r; asm volatile("v_cvt_pk_bf16_f32 %0, %1, %2" : "=v"(r) : "v"(lo), "v"(hi)); return r;
}
template <typename TIn> struct Stage;
template <> struct Stage<bf16>  { using T = bf16x8;
  __device__ static __forceinline__ T ld8(const bf16* p) { return *reinterpret_cast<const bf16x8*>(p); }
  __device__ static __forceinline__ bf16x8 tobf(T x) { return x; } };
template <> struct Stage<float> { using T = f32x8;
  __device__ static __forceinline__ T ld8(const float* p) { return *reinterpret_cast<const f32x8*>(p); }
  __device__ static __forceinline__ bf16x8 tobf(T x) {
    u32x4 w = {cvtpk(x[0], x[1]), cvtpk(x[2], x[3]), cvtpk(x[4], x[5]), cvtpk(x[6], x[7])}; return *reinterpret_cast<bf16x8*>(&w); } };

__device__ __forceinline__ void partialSM(f32x16& p0, f32x16& p1, float& m_reg, float& mn, float& alpha) {
  constexpr float C = SCALE * 1.4426950408889634f;
  float pmax = p0[0]; for (int r = 1; r < 16; ++r) pmax = fmaxf(pmax, p0[r]); for (int r = 0; r < 16; ++r) pmax = fmaxf(pmax, p1[r]);
  { auto rr = __builtin_amdgcn_permlane32_swap(__float_as_uint(pmax), __float_as_uint(pmax), false, false);
    pmax = fmaxf(__uint_as_float(rr[0]), __uint_as_float(rr[1])); }
  if (__builtin_expect(__all(pmax - m_reg <= THR / SCALE), 1)) { mn = m_reg; alpha = 1.f; }
  else { mn = fmaxf(m_reg, pmax); alpha = __builtin_amdgcn_exp2f((m_reg - mn) * C); m_reg = mn; }
  float mnC = -mn * C;
  for (int r = 0; r < 16; ++r) p0[r] = fmaf(p0[r], C, mnC); for (int r = 0; r < 16; ++r) p1[r] = fmaf(p1[r], C, mnC);
  for (int r = 0; r < 16; ++r) p0[r] = __builtin_amdgcn_exp2f(p0[r]);
}
__device__ __forceinline__ void finishSM(f32x16& p0, f32x16& p1, float alpha, float& l_reg, bf16x8& pa0, bf16x8& pa1, bf16x8& pa2, bf16x8& pa3) {
  for (int r = 0; r < 16; ++r) p1[r] = __builtin_amdgcn_exp2f(p1[r]);
  float ps = 0; for (int r = 0; r < 16; ++r) ps += p0[r]; for (int r = 0; r < 16; ++r) ps += p1[r];
  { auto rr = __builtin_amdgcn_permlane32_swap(__float_as_uint(ps), __float_as_uint(ps), false, false);
    ps = __uint_as_float(rr[0]) + __uint_as_float(rr[1]); }
  l_reg = l_reg * alpha + ps;
#define PK4(P, BASE, OUT) do { unsigned a0 = cvtpk(P[BASE + 0], P[BASE + 1]), a1 = cvtpk(P[BASE + 2], P[BASE + 3]);   \
    unsigned b0 = cvtpk(P[BASE + 4], P[BASE + 5]), b1 = cvtpk(P[BASE + 6], P[BASE + 7]);                              \
    auto r0 = __builtin_amdgcn_permlane32_swap(a0, b0, false, false); auto r1 = __builtin_amdgcn_permlane32_swap(a1, b1, false, false); \
    u32x4 w = {r0[0], r1[0], r0[1], r1[1]}; OUT = *reinterpret_cast<bf16x8*>(&w); } while (0)
  PK4(p0, 0, pa0); PK4(p0, 8, pa1); PK4(p1, 0, pa2); PK4(p1, 8, pa3);
#undef PK4
}
__device__ __forceinline__ void qkt(f32x16& p0, f32x16& p1, const bf16* Ks, const bf16x8* qr, int r32, int hi) {
  p0 = f32x16{}; p1 = f32x16{};
  for (int d0 = 0; d0 < 8; ++d0) { int cb = (d0 * 16 + hi * 8) * 2;
    bf16x8 b0 = *reinterpret_cast<const bf16x8*>((const char*)Ks + KSWZ(r32, cb));
    bf16x8 b1 = *reinterpret_cast<const bf16x8*>((const char*)Ks + KSWZ(32 + r32, cb));
    p0 = __builtin_amdgcn_mfma_f32_32x32x16_bf16(b0, qr[d0], p0, 0, 0, 0);
    p1 = __builtin_amdgcn_mfma_f32_32x32x16_bf16(b1, qr[d0], p1, 0, 0, 0); }
}
__device__ __forceinline__ int v_st(int k, int c) { const int kk = (k & ~0xC) | ((k & 4) << 1) | ((k & 8) >> 1); return ((kk >> 3) * 4 + (c >> 5)) * 512 + ((kk & 7) * 32 + (c & 31)) * 2; }
__device__ __forceinline__ int v_rd_base(int lane) { return ((lane & 3) << 3) | (((lane >> 2) & 3) << 6) | (((lane >> 4) & 1) << 5) | (((lane >> 5) & 1) << 8); }
constexpr int v_rd_off(int d0, int ks, int half) { return d0 * 512 + ks * 4096 + half * 2048; }
template <int OFF> __device__ __forceinline__ s16x4 tr_read(int vb) {
  s16x4 r; asm volatile("ds_read_b64_tr_b16 %0, %1 offset:%2" : "=&v"(r) : "v"(vb), "i"(OFF) : "memory"); return r;
}
template <int D0> __device__ __forceinline__ void pv_one(f32x16& od, int vb, bf16x8 pa0, bf16x8 pa1, bf16x8 pa2, bf16x8 pa3) {
  const s16x4 l0 = tr_read<v_rd_off(D0, 0, 0)>(vb), h0 = tr_read<v_rd_off(D0, 0, 1)>(vb), l1 = tr_read<v_rd_off(D0, 1, 0)>(vb), h1 = tr_read<v_rd_off(D0, 1, 1)>(vb);
  const s16x4 l2 = tr_read<v_rd_off(D0, 2, 0)>(vb), h2 = tr_read<v_rd_off(D0, 2, 1)>(vb), l3 = tr_read<v_rd_off(D0, 3, 0)>(vb), h3 = tr_read<v_rd_off(D0, 3, 1)>(vb);
  asm volatile("s_waitcnt lgkmcnt(0)" ::: "memory"); SBAR();
#define PK(L, H) (bf16x8){L[0], L[1], L[2], L[3], H[0], H[1], H[2], H[3]}
  od = __builtin_amdgcn_mfma_f32_32x32x16_bf16(pa0, PK(l0, h0), od, 0, 0, 0);
  od = __builtin_amdgcn_mfma_f32_32x32x16_bf16(pa1, PK(l1, h1), od, 0, 0, 0);
  od = __builtin_amdgcn_mfma_f32_32x32x16_bf16(pa2, PK(l2, h2), od, 0, 0, 0);
  od = __builtin_amdgcn_mfma_f32_32x32x16_bf16(pa3, PK(l3, h3), od, 0, 0, 0);
#undef PK
}
__device__ __forceinline__ void pv_d0(f32x16* o, int vb, bf16x8 pa0, bf16x8 pa1, bf16x8 pa2, bf16x8 pa3) {
  pv_one<0>(o[0], vb, pa0, pa1, pa2, pa3); pv_one<1>(o[1], vb, pa0, pa1, pa2, pa3); pv_one<2>(o[2], vb, pa0, pa1, pa2, pa3); pv_one<3>(o[3], vb, pa0, pa1, pa2, pa3);
}
struct DenseTiles { int base;
  __device__ __forceinline__ int krow(int j) const { return base + j * KVBLK; }
  __device__ __forceinline__ void mask(f32x16&, f32x16&, int, int, int, int) const {} };
__device__ __forceinline__ void partialSM_fix(f32x16& p0, f32x16& p1, float mfixC) {
#pragma unroll
  for (int r = 0; r < 16; ++r) p0[r] = __builtin_amdgcn_exp2f(p0[r]);
}
template <int ld, class TF, bool FIX>
__device__ __forceinline__ void attn_body(const bf16* __restrict__ Qb, const bf16* __restrict__ Kh, const bf16* __restrict__ Vh, const bf16* __restrict__ Gb,
                                          bf16* __restrict__ Ob, int NT, const TF& T, char* lds, float mfixC) {
  using St = Stage<bf16>;
  const int tid = ltid(), wid = tid >> 6, lane = tid & 63, r32 = lane & 31, hi = lane >> 5;
  bf16* V_lds = (bf16*)lds; bf16* K_lds = (bf16*)(lds + 2 * SHM_V);
  float* ws = (float*)(lds + 2 * SHM_V + 2 * SHM_K) + wid * 64; float* li_l = ws; float* al_l = ws + 32;
  float m_reg = -1e30f, l_reg = 0; f32x16 o[4] = {}; bf16x8 qr[8];
  const bf16* Qw = Qb + (long)(wid * QBLK + r32) * ld + hi * 8;
#pragma unroll
  for (int d0 = 0; d0 < 8; ++d0) qr[d0] = St::ld8(Qw + d0 * 16);
  const int sr = tid >> 4, sc = (tid & 15) * 8, vst0 = v_st(sr, sc), vst1 = v_st(32 + sr, sc);
  const int vb0 = (int)(uintptr_t)V_lds + v_rd_base(lane);
  struct { typename St::T vs0, vs1, ks0, ks1; } sr_[SDEPTH];
#define SLOAD(i, k0) do { const long _k0 = (k0); sr_[i].vs0 = St::ld8(&Vh[(_k0 + sr) * ld + sc]); sr_[i].vs1 = St::ld8(&Vh[(_k0 + 32 + sr) * ld + sc]); \
    sr_[i].ks0 = St::ld8(&Kh[(_k0 + sr) * ld + sc]); sr_[i].ks1 = St::ld8(&Kh[(_k0 + 32 + sr) * ld + sc]); } while (0)
#define SWRITE(b, i) do { *(bf16x8*)((char*)V_lds + (b) * SHM_V + vst0) = St::tobf(sr_[i].vs0);          \
    *(bf16x8*)((char*)V_lds + (b) * SHM_V + vst1) = St::tobf(sr_[i].vs1); int kc = sc * 2;               \
    *(bf16x8*)((char*)K_lds + (b) * SHM_K + KSWZ(sr, kc)) = St::tobf(sr_[i].ks0);                       \
    *(bf16x8*)((char*)K_lds + (b) * SHM_K + KSWZ(32 + sr, kc)) = St::tobf(sr_[i].ks1); } while (0)
#define SWAIT() do { if constexpr (SDEPTH == 2) asm volatile("s_waitcnt vmcnt(4)" ::: "memory"); else asm volatile("s_waitcnt vmcnt(0)" ::: "memory"); } while (0)
#define RESC(a) do { if (__any((a) < 1.f)) { if (hi == 0) al_l[r32] = (a); asm volatile("s_waitcnt lgkmcnt(0)" ::: "memory"); \
    for (int d = 0; d < 4; ++d) for (int r = 0; r < 16; ++r) o[d][r] *= al_l[crow(r, hi)]; } } while (0)
  f32x16 pA0, pA1, pB0, pB1; float mnA, mnB, alA, alB; bf16x8 pa0, pa1, pa2, pa3;
  constexpr int SE = 0, SO = SDEPTH - 1;
  SLOAD(SE, T.krow(0)); asm volatile("s_waitcnt vmcnt(0)" ::: "memory"); SWRITE(0, SE); __syncthreads();
  qkt(pA0, pA1, K_lds, qr, r32, hi); T.mask(pA0, pA1, 0, wid, r32, hi); if constexpr (FIX) { partialSM_fix(pA0, pA1, mfixC); alA = 1.f; } else partialSM(pA0, pA1, m_reg, mnA, alA);
  SLOAD(SO, T.krow(1)); if constexpr (SDEPTH == 2) { if (2 < NT) SLOAD(SE, T.krow(2)); }
  SWAIT(); SWRITE(1, SO); __syncthreads();
  for (int j = 1; j + 1 < NT; j += 2) {
    SBAR(); qkt(pB0, pB1, (bf16*)((char*)K_lds + SHM_K), qr, r32, hi); T.mask(pB0, pB1, j, wid, r32, hi);
    finishSM(pA0, pA1, alA, l_reg, pa0, pa1, pa2, pa3); SBAR();
    SLOAD(SO, T.krow(j + SDEPTH)); SBAR();
    pv_d0(o, vb0, pa0, pa1, pa2, pa3); if constexpr (FIX) { partialSM_fix(pB0, pB1, mfixC); alB = 1.f; } else partialSM(pB0, pB1, m_reg, mnB, alB);
    __syncthreads(); SWAIT(); SWRITE(0, SE);
    if constexpr (!FIX) RESC(alB); __syncthreads();
    SBAR(); qkt(pA0, pA1, K_lds, qr, r32, hi); T.mask(pA0, pA1, j + 1, wid, r32, hi);
    finishSM(pB0, pB1, alB, l_reg, pa0, pa1, pa2, pa3); SBAR();
    if (SDEPTH == 1 || j + 3 < NT) SLOAD(SE, T.krow(j + 1 + SDEPTH)); SBAR();
    pv_d0(o, vb0 + (int)SHM_V, pa0, pa1, pa2, pa3); if constexpr (FIX) { partialSM_fix(pA0, pA1, mfixC); alA = 1.f; } else partialSM(pA0, pA1, m_reg, mnA, alA);
    __syncthreads(); SWAIT(); SWRITE(1, SO);
    if constexpr (!FIX) RESC(alA); __syncthreads();
  }
  SBAR(); qkt(pB0, pB1, (bf16*)((char*)K_lds + SHM_K), qr, r32, hi); T.mask(pB0, pB1, NT - 1, wid, r32, hi);
  finishSM(pA0, pA1, alA, l_reg, pa0, pa1, pa2, pa3); SBAR();
  pv_d0(o, vb0, pa0, pa1, pa2, pa3); if constexpr (FIX) { partialSM_fix(pB0, pB1, mfixC); alB = 1.f; } else partialSM(pB0, pB1, m_reg, mnB, alB);
  __syncthreads(); if constexpr (!FIX) RESC(alB);
  finishSM(pB0, pB1, alB, l_reg, pa0, pa1, pa2, pa3); SBAR();
  pv_d0(o, vb0 + (int)SHM_V, pa0, pa1, pa2, pa3);
  if (hi == 0) li_l[r32] = l_reg; asm volatile("s_waitcnt lgkmcnt(0)" ::: "memory");
  float rli[16];
#pragma unroll
  for (int r = 0; r < 16; ++r) rli[r] = __builtin_amdgcn_rcpf(li_l[crow(r, hi)]);
  __syncthreads();
  bf16* ot = (bf16*)lds + wid * (32 * 136);
#pragma unroll
  for (int r = 0; r < 16; ++r) { const int orow = crow(r, hi);
#pragma unroll
    for (int d0 = 0; d0 < 4; ++d0) ot[orow * 136 + d0 * 32 + r32] = ::f2bf(o[d0][r] * rli[r]); }
  asm volatile("s_waitcnt lgkmcnt(0)" ::: "memory");
  bf16* Ow = (bf16*)((unsigned char*)Ob + (long)(wid * QBLK) * 2048); const bf16* Gw = Gb + (long)(wid * QBLK) * ld;
#pragma unroll 2
  for (int c = 0; c < 8; ++c) { const int idx = c * 64 + lane, row = idx >> 4, ch = (idx & 15) * 8;
    const u32x4 ov = *(const u32x4*)(ot + row * 136 + ch); const u32x4 gv = *(const u32x4*)(Gw + (long)row * ld + ch); float f[8];
#pragma unroll
    for (int e = 0; e < 4; ++e) { const float g0 = ::bf_lo(gv[e]), g1 = ::bf_hi(gv[e]); f[2 * e] = ::bf_lo(ov[e]) * ::siluf_(g0) * OG_SCALE; f[2 * e + 1] = ::bf_hi(ov[e]) * ::siluf_(g1) * OG_SCALE; }
    u32x2 w; w.x = ::pack4_fp8_sat((f32x4){f[0], f[1], f[2], f[3]}); w.y = ::pack4_fp8_sat((f32x4){f[4], f[5], f[6], f[7]});
    *(u32x2*)((unsigned char*)Ow + (long)row * 2048 + ch) = w; }
  __syncthreads();
#undef SLOAD
#undef SWRITE
#undef SWAIT
#undef RESC
}

__device__ __forceinline__ void na_wave(const bf16* __restrict__ PB, bf16* __restrict__ OG, const float* rpb, int qrow, int c0, int h, char* wlds, int lane) {
  constexpr int ld = LDE;
  const int r32 = lane & 31, hi = lane >> 5;
  const bf16* Qw = PB + (size_t)(qrow * 64 + c0 + r32) * ld + h * 128 + hi * 8;
  bf16x8 qr[8];
#pragma unroll
  for (int d0 = 0; d0 < 8; ++d0) qr[d0] = *(const bf16x8*)(Qw + d0 * 16);
  float m_reg = -1e30f, l_reg = 0.f; f32x16 o[4] = {};
  float* al_l = (float*)(wlds + 16384);
  int rs = qrow - 4; rs = rs < 0 ? 0 : (rs > 120 ? 120 : rs);
  const int qc = c0 + r32; int cs = qc - 8; cs = cs < 0 ? 0 : (cs > 48 ? 48 : cs);
  const int vb0 = (int)(uintptr_t)wlds + v_rd_base(lane);
  const int skey = lane >> 4, scol = (lane & 15) * 8;
  for (int j = 0; j < 12; ++j) {
    const int krow = j < 4 ? SEQ + 64 * j : (rs + j - 4) * 64;
    const bf16* Kt = PB + (size_t)krow * ld + 1024 + h * 128; const bf16* Vt = Kt + 1024;
#pragma unroll
    for (int hf = 0; hf < 2; ++hf) { bf16x8 v[8];
#pragma unroll
      for (int it = 0; it < 8; ++it) v[it] = *(const bf16x8*)(Vt + (size_t)((hf * 8 + it) * 4 + skey) * ld + scol);
#pragma unroll
      for (int it = 0; it < 8; ++it) *(bf16x8*)(wlds + v_st((hf * 8 + it) * 4 + skey, scol)) = v[it]; }
    f32x16 p0 = {}, p1 = {};
#pragma unroll
    for (int d0 = 0; d0 < 8; ++d0) { const bf16x8 b0 = *(const bf16x8*)(Kt + (size_t)r32 * ld + d0 * 16 + hi * 8), b1 = *(const bf16x8*)(Kt + (size_t)(32 + r32) * ld + d0 * 16 + hi * 8);
      p0 = __builtin_amdgcn_mfma_f32_32x32x16_bf16(b0, qr[d0], p0, 0, 0, 0); p1 = __builtin_amdgcn_mfma_f32_32x32x16_bf16(b1, qr[d0], p1, 0, 0, 0); }
    if (j >= 4) { const int bi = (rs + j - 4 - qrow + 7) * 31 - qc + 15;
#pragma unroll
      for (int r = 0; r < 16; ++r) { const int kc = crow(r, hi);
        { const bool ok = (kc >= cs) && (kc < cs + 16); const float b = rpb[ok ? bi + kc : 0]; p0[r] = ok ? p0[r] + b : -1e30f; }
        { const int k1 = kc + 32; const bool ok = (k1 >= cs) && (k1 < cs + 16); const float b = rpb[ok ? bi + k1 : 0]; p1[r] = ok ? p1[r] + b : -1e30f; } } }
#ifdef EXP_NA_UNIFORM
#pragma unroll
    for (int r = 0; r < 16; ++r) { if (p0[r] > -1e29f) p0[r] = 0.f; if (p1[r] > -1e29f) p1[r] = 0.f; }
#endif
    float mn, alpha; bf16x8 pa0, pa1, pa2, pa3;
    partialSM(p0, p1, m_reg, mn, alpha);
    finishSM(p0, p1, alpha, l_reg, pa0, pa1, pa2, pa3);
    if (__any(alpha < 1.f)) { if (hi == 0) al_l[r32] = alpha; asm volatile("s_waitcnt lgkmcnt(0)" ::: "memory");
#pragma unroll
      for (int d = 0; d < 4; ++d)
#pragma unroll
        for (int r = 0; r < 16; ++r) o[d][r] *= al_l[crow(r, hi)]; }
    pv_d0(o, vb0, pa0, pa1, pa2, pa3);
  }
  if (hi == 0) al_l[r32] = l_reg; asm volatile("s_waitcnt lgkmcnt(0)" ::: "memory");
  float rli[16];
#pragma unroll
  for (int r = 0; r < 16; ++r) rli[r] = __builtin_amdgcn_rcpf(al_l[crow(r, hi)]);
  bf16* ot = (bf16*)wlds;
#pragma unroll
  for (int r = 0; r < 16; ++r) { const int orow = crow(r, hi);
#pragma unroll
    for (int d0 = 0; d0 < 4; ++d0) ot[orow * 136 + d0 * 32 + r32] = ::f2bf(o[d0][r] * rli[r]); }
  asm volatile("s_waitcnt lgkmcnt(0)" ::: "memory");
  const size_t t0 = (size_t)(qrow * 64 + c0);
#pragma unroll 2
  for (int c = 0; c < 8; ++c) { const int idx = c * 64 + lane, row = idx >> 4, ch = (idx & 15) * 8;
    const u32x4 ov = *(const u32x4*)(ot + row * 136 + ch); const u32x4 gv = *(const u32x4*)(PB + (t0 + row) * ld + 3072 + h * 128 + ch); float f[8];
#pragma unroll
    for (int e = 0; e < 4; ++e) { const float g0 = ::bf_lo(gv[e]), g1 = ::bf_hi(gv[e]); f[2 * e] = ::bf_lo(ov[e]) * ::siluf_(g0) * OG_SCALE; f[2 * e + 1] = ::bf_hi(ov[e]) * ::siluf_(g1) * OG_SCALE; }
    u32x2 w; w.x = ::pack4_fp8_sat((f32x4){f[0], f[1], f[2], f[3]}); w.y = ::pack4_fp8_sat((f32x4){f[4], f[5], f[6], f[7]});
    *(u32x2*)((unsigned char*)OG + (t0 + row) * 2048 + h * 128 + ch) = w; }
  asm volatile("s_waitcnt lgkmcnt(0)" ::: "memory");
}
}

constexpr size_t MiB = 1u << 20;
constexpr size_t WS_WEVIN = 1 * MiB, WS_WEVOUT = 49 * MiB, WS_WGLU = 65 * MiB, WS_WODIN = 69 * MiB, WS_WODOUT = 109 * MiB;
constexpr size_t WS_T1 = 125 * MiB, WS_T2 = 141 * MiB, WS_LAM = 173 * MiB;
constexpr size_t WS_MODP = 430 * MiB, WS_MOD = 178 * MiB;
constexpr size_t WS_X = 179 * MiB, WS_H = 245 * MiB, WS_P = 278 * MiB, WS_OG = 380 * MiB, WS_ZB = 413 * MiB, WS_S = 430 * MiB, WS_HB = 463 * MiB, WS_END = 480 * MiB;
constexpr int LDS_BYTES = 131072 + 8192;
constexpr int NPH = 27;

struct Params {
    const float *x, *c, *ctx, *c_ctx, *ada_w, *ada_b, *ln_g, *ln_b, *ev_w_in, *ev_w_out, *na_rpb, *s5_a_re, *s5_a_im, *s5_log_dt, *s5_b_re, *s5_b_im, *s5_c_re, *s5_c_im, *s5_d,
        *s5_glu_w, *s5_glu_b, *od_w_in, *od_w_out, *q_norm_g, *k_norm_g;
    float* out; unsigned char* ws; int ph_lo, ph_hi;
};

struct TrItem { const float* W; bf16_t* WT; int K, N, item; float sc; bool fp8; };
__device__ __forceinline__ void tr_load(const TrItem& m, int lane, f32x4 (&v)[16]) {
    const int nblk = m.N / 64, kb = m.item / nblk, nb = m.item % nblk, k0 = 64 * kb, n0 = 64 * nb;
#pragma unroll
    for (int i = 0; i < 16; ++i) v[i] = *(const f32x4*)(m.W + (size_t)(k0 + 4 * i + (lane >> 4)) * m.N + n0 + (lane & 15) * 4);
}
__device__ __forceinline__ void tr_store(const TrItem& m, int lane, const f32x4 (&v)[16], LAS float* scr) {
    const int nblk = m.N / 64, kb = m.item / nblk, nb = m.item % nblk, k0 = 64 * kb, n0 = 64 * nb, K = m.K;
#pragma unroll
    for (int i = 0; i < 16; ++i) { LAS float* d = scr + (4 * i + (lane >> 4)) * 65 + (lane & 15) * 4; d[0] = v[i][0]; d[1] = v[i][1]; d[2] = v[i][2]; d[3] = v[i][3]; }
    asm volatile("s_waitcnt lgkmcnt(0)" ::: "memory");
    const int c = lane & 7;
#pragma unroll
    for (int j = 0; j < 8; ++j) { const int n = (lane >> 3) + 8 * j; const LAS float* s = scr + (8 * c) * 65 + n;
        if (m.fp8) { u32x2 o; o.x = pack4_fp8((f32x4){s[0 * 65], s[1 * 65], s[2 * 65], s[3 * 65]} * m.sc); o.y = pack4_fp8((f32x4){s[4 * 65], s[5 * 65], s[6 * 65], s[7 * 65]} * m.sc);
            *(u32x2*)((unsigned char*)m.WT + (size_t)(n0 + n) * K + k0 + 8 * c) = o; }
        else { u32x4 o; o.x = cvt_pk_bf16(s[0 * 65], s[1 * 65]); o.y = cvt_pk_bf16(s[2 * 65], s[3 * 65]); o.z = cvt_pk_bf16(s[4 * 65], s[5 * 65]); o.w = cvt_pk_bf16(s[6 * 65], s[7 * 65]);
            *(u32x4*)(m.WT + (size_t)(n0 + n) * K + k0 + 8 * c) = o; } }
    asm volatile("s_waitcnt lgkmcnt(0)" ::: "memory");
}

__device__ __forceinline__ void s5_tables_item(const Params& P, int i, int g, LAS float* L) {
    LAS float* pw = L;
    LAS float* BbRe = L + 4352;
    LAS float* BbIm = BbRe + 2048;
    LAS float* CRe = BbIm + 2048;
    LAS float* CIm = CRe + 2048;
    LAS float* Kt = CIm + 2048;
    const int tid = ltid();
    bf16_t* T1 = (bf16_t*)(lws(P.ws) + WS_T1) + (size_t)(i * 64 + g) * 256 * 256;
    bf16_t* T2 = (bf16_t*)(lws(P.ws) + WS_T2) + (size_t)(i * 64 + g) * 256 * 512;
    float* LAM = (float*)(lws(P.ws) + WS_LAM) + (size_t)(i * 64 + g) * 256;
    __syncthreads();
    if (tid < 128) {
        const int dir = tid >> 6, pp = tid & 63, idx = (i * 2 + dir) * 64 + g;
        const float dt = __expf(P.s5_log_dt[idx]), are = P.s5_a_re[idx * 64 + pp], aim = P.s5_a_im[idx * 64 + pp];
        const float mag = __expf(are * dt); float rev = aim * dt * 0.15915494309189535f; rev -= floorf(rev);
        const float lre = mag * __builtin_amdgcn_cosf(rev), lim = mag * __builtin_amdgcn_sinf(rev);
        const float den = are * are + aim * aim, nre = lre - 1.f, nim = lim;
        const float fre = (nre * are + nim * aim) / den, fim = (nim * are - nre * aim) / den;
        float cr = 1.f, ci = 0.f;
        for (int d = 0; d <= 16; ++d) { pw[((dir * 17 + d) * 64 + pp) * 2] = cr; pw[((dir * 17 + d) * 64 + pp) * 2 + 1] = ci; const float nr = cr * lre - ci * lim, ni = cr * lim + ci * lre; cr = nr; ci = ni; }
        LAM[(dir * 64 + pp) * 2] = pw[((dir * 17 + 16) * 64 + pp) * 2]; LAM[(dir * 64 + pp) * 2 + 1] = pw[((dir * 17 + 16) * 64 + pp) * 2 + 1];
        for (int c = 0; c < 16; ++c) { const float bre = P.s5_b_re[(size_t)(idx * 64 + pp) * 16 + c], bim = P.s5_b_im[(size_t)(idx * 64 + pp) * 16 + c];
            BbRe[(dir * 64 + pp) * 16 + c] = fre * bre - fim * bim; BbIm[(dir * 64 + pp) * 16 + c] = fre * bim + fim * bre; }
    }
    for (int e = tid; e < 2048; e += 512) { const int dir = e >> 10, r = e & 1023; const size_t src = (size_t)((i * 2 + dir) * 64 + g) * 1024 + r; CRe[e] = P.s5_c_re[src]; CIm[e] = P.s5_c_im[src]; }
    __syncthreads();
    {   const int dir = tid >> 8, d = (tid >> 4) & 15, co = tid & 15; float acc[16];
#pragma unroll
        for (int c = 0; c < 16; ++c) acc[c] = 0.f;
        for (int pp = 0; pp < 64; ++pp) { const float cr = CRe[(dir * 16 + co) * 64 + pp], ci = CIm[(dir * 16 + co) * 64 + pp], wr_ = pw[((dir * 17 + d) * 64 + pp) * 2], wi = pw[((dir * 17 + d) * 64 + pp) * 2 + 1];
            const float gre = cr * wr_ - ci * wi, gim = cr * wi + ci * wr_;
#pragma unroll
            for (int c = 0; c < 16; ++c) acc[c] += gre * BbRe[(dir * 64 + pp) * 16 + c] - gim * BbIm[(dir * 64 + pp) * 16 + c]; }
#pragma unroll
        for (int c = 0; c < 16; ++c) Kt[((dir * 16 + d) * 16 + co) * 16 + c] = acc[c];
    }
    __syncthreads();
    for (int ch = tid; ch < 16384; ch += 512) {
        const int f = ch >> 6, cc = ch & 63, t = f >> 4, co = f & 15; float v[8];
        if (cc < 32) { const int s = cc >> 1, ci0 = (cc & 1) * 8;
#pragma unroll
            for (int e = 0; e < 8; ++e) { const int ci = ci0 + e; float a = 0.f;
#ifndef EXP_NO_SCAN
                if (t >= s) a += Kt[((0 * 16 + (t - s)) * 16 + co) * 16 + ci];
                if (s >= t) a += Kt[((1 * 16 + (s - t)) * 16 + co) * 16 + ci];
#endif
                if (s == t && co == ci) a += P.s5_d[i * 1024 + g * 16 + co];
                v[e] = a; }
        } else { const int q = (cc - 32) >> 3, p0 = ((cc - 32) & 7) * 8, dir = q >> 1, im = q & 1, pwr = dir == 0 ? t + 1 : 16 - t;
#pragma unroll
            for (int e = 0; e < 8; ++e) { const int pp = p0 + e; const float cr = CRe[(dir * 16 + co) * 64 + pp], ci = CIm[(dir * 16 + co) * 64 + pp], wr_ = pw[((dir * 17 + pwr) * 64 + pp) * 2], wi = pw[((dir * 17 + pwr) * 64 + pp) * 2 + 1];
                v[e] = im ? -(cr * wi + ci * wr_) : (cr * wr_ - ci * wi);
#if defined(EXP_NO_SCAN) || defined(EXP_NO_CARRY)
                v[e] = 0.f;
#endif
#ifdef EXP_NO_CARRY_B
                if (dir == 1) v[e] = 0.f;
#endif
            } }
        u32x4 w; w.x = cvt_pk_bf16(v[0], v[1]); w.y = cvt_pk_bf16(v[2], v[3]); w.z = cvt_pk_bf16(v[4], v[5]); w.w = cvt_pk_bf16(v[6], v[7]);
        *(u32x4*)(T2 + ((size_t)(((f >> 5) * 32 + (cc >> 1)) * 64 + (cc & 1) * 32 + (f & 31))) * 8) = w;
    }
    for (int ch = tid; ch < 8192; ch += 512) {
        const int row = ch >> 5, cc = ch & 31, s = cc >> 1, ci0 = (cc & 1) * 8, dir = row >> 7, im = (row >> 6) & 1, pp = row & 63, pwr = dir == 0 ? 15 - s : s; float v[8];
        const float wr_ = pw[((dir * 17 + pwr) * 64 + pp) * 2], wi = pw[((dir * 17 + pwr) * 64 + pp) * 2 + 1];
#pragma unroll
        for (int e = 0; e < 8; ++e) { const float br = BbRe[(dir * 64 + pp) * 16 + ci0 + e], bi = BbIm[(dir * 64 + pp) * 16 + ci0 + e]; v[e] = im ? (wr_ * bi + wi * br) : (wr_ * br - wi * bi); }
        u32x4 w; w.x = cvt_pk_bf16(v[0], v[1]); w.y = cvt_pk_bf16(v[2], v[3]); w.z = cvt_pk_bf16(v[4], v[5]); w.w = cvt_pk_bf16(v[6], v[7]);
        *(u32x4*)(T1 + ((size_t)(((row >> 5) * 16 + (cc >> 1)) * 64 + (cc & 1) * 32 + (row & 31))) * 8) = w;
    }
    __syncthreads();
}

__device__ __forceinline__ TrItem seg_item(const Params& P, unsigned char* ws, int seg, int j) {
    TrItem m; m.K = 2048; m.N = 2048; m.fp8 = true; m.sc = WOUT_SCALE;
    const int i = seg >= 2 ? 1 : 0;
    if (seg == 0 || (seg == 2 && j < 3072)) { m.W = P.ev_w_in + (size_t)i * 2048 * 6144; m.N = 6144; m.sc = WIN_SCALE; m.WT = (bf16_t*)(ws + WS_WEVIN + (size_t)i * 6144 * 2048); }
    else if (seg == 1 || seg == 2) {
        if (seg == 2) j -= 3072;
        if (j < 1024) { m.W = P.ev_w_out + (size_t)i * 2048 * 2048; m.WT = (bf16_t*)(ws + WS_WEVOUT + (size_t)i * 2048 * 2048); }
        else if ((j -= 1024) < 256) { m.W = P.s5_glu_w + (size_t)i * 1024 * 1024; m.K = 1024; m.N = 1024; m.fp8 = false; m.sc = 1.f; m.WT = (bf16_t*)(ws + WS_WGLU) + (size_t)i * 1024 * 1024; }
        else if ((j -= 256) < 2560) { m.W = P.od_w_in + (size_t)i * 2048 * 5120; m.N = 5120; m.sc = WIN_SCALE; m.WT = (bf16_t*)(ws + WS_WODIN + (size_t)i * 5120 * 2048); }
        else { j -= 2560; m.W = P.od_w_out + (size_t)i * 2048 * 2048; m.WT = (bf16_t*)(ws + WS_WODOUT + (size_t)i * 2048 * 2048); }
    } else if (seg == 3) { m.W = P.od_w_in + (size_t)i * 2048 * 5120; m.N = 5120; m.sc = WIN_SCALE; m.WT = (bf16_t*)(ws + WS_WODIN + (size_t)i * 5120 * 2048); }
    else { m.W = P.od_w_out + (size_t)i * 2048 * 2048; m.WT = (bf16_t*)(ws + WS_WODOUT + (size_t)i * 2048 * 2048); }
    m.item = j; return m;
}
__device__ __forceinline__ void convert_seg(const Params& P, int seg, int vw, int nvw, LAS float* scr, int lane) {
    unsigned char* ws = lws(P.ws);
    const int nitems = seg == 0 ? 3072 : seg == 1 ? 4864 : seg == 2 ? 4352 : seg == 3 ? 2560 : 1024;
    f32x4 va[16], vb[16]; TrItem m0, m1; int j = vw;
    if (j < nitems) { m0 = seg_item(P, ws, seg, j); tr_load(m0, lane, va); }
    while (j < nitems) {
        const int j1 = j + nvw, j2 = j1 + nvw;
        if (j1 < nitems) { m1 = seg_item(P, ws, seg, j1); tr_load(m1, lane, vb); }
        tr_store(m0, lane, va, scr);
        if (j2 < nitems) { m0 = seg_item(P, ws, seg, j2); tr_load(m0, lane, va); }
        if (j1 < nitems) tr_store(m1, lane, vb, scr);
        j = j2;
    }
}
__device__ __forceinline__ void phase_prologue(const Params& P, LAS unsigned char* lds) {
    const int tid = ltid(), lane = tid & 63, wid = tid >> 6, G = gridDim.x;
    unsigned char* ws = lws(P.ws);
    if (lbid() < 128) s5_tables_item(P, lbid() >> 6, lbid() & 63, (LAS float*)lds);
    __syncthreads();
    {
        LAS float* sv = (LAS float*)lds;
        for (int e = tid; e < 2048; e += 512) { sv[e] = siluf_(P.c[e]); sv[2048 + e] = siluf_(P.c_ctx[e]); }
        __syncthreads();
        float* MODP = (float*)(ws + WS_MODP);
        for (int it = lbid(); it < 768; it += G) {
            const int l = it / 192, rem = it % 192, cb = rem >> 6, ks = rem & 63, col = cb * 2048 + tid * 4;
            const float* w = P.ada_w + ((size_t)l * 2048 + ks * 32) * 6144 + col; f32x4 a0 = {0.f, 0.f, 0.f, 0.f}, a1 = {0.f, 0.f, 0.f, 0.f};
#pragma unroll 16
            for (int k = 0; k < 32; ++k) { const f32x4 wv = *(const f32x4*)(w + (size_t)k * 6144); a0 += wv * sv[ks * 32 + k]; a1 += wv * sv[2048 + ks * 32 + k]; }
            *(f32x4*)(MODP + ((size_t)(l * 64 + ks) * 2 + 0) * 6144 + col) = a0; *(f32x4*)(MODP + ((size_t)(l * 64 + ks) * 2 + 1) * 6144 + col) = a1;
        }
    }
    __syncthreads();
    if (lbid() >= 128) convert_seg(P, 0, (lbid() - 128) * 8 + wid, (G - 128) * 8, (LAS float*)(lds + wid * 16640), lane);
}

__device__ __forceinline__ void phase_finalize_mod(const Params& P) {
    const float* MODP = (const float*)(lws(P.ws) + WS_MODP); float* MOD = (float*)(lws(P.ws) + WS_MOD);
    for (int e = lbid() * 512 + ltid(); e < 4 * 2 * 6144; e += gridDim.x * 512) {
        const int l = e / 12288, v = (e / 6144) & 1, col = e % 6144; float s = P.ada_b[l * 6144 + col];
        for (int ks = 0; ks < 64; ++ks) s += MODP[((size_t)(l * 64 + ks) * 2 + v) * 6144 + col];
        MOD[e] = s;
    }
}
__device__ __forceinline__ void mod_row(const f32x4 (&v)[8], const float* sh, const float* sc, bf16_t* hrow, int lane) {
#pragma unroll
    for (int j = 0; j < 8; ++j) { const int col = 4 * lane + 256 * j; const f32x4 s = *(const f32x4*)(sc + col), t = *(const f32x4*)(sh + col); const f32x4 h = v[j] * (s + 1.f) + t;
        *(unsigned*)((unsigned char*)hrow + col) = pack4_fp8(h); }
}
__device__ __forceinline__ void phase_mod0(const Params& P) {
    const int lane = ltid() & 63, gw = lbid() * 8 + (ltid() >> 6), NGW = gridDim.x * 8;
    const float* MOD = (const float*)(lws(P.ws) + WS_MOD); unsigned char* H = lws(P.ws) + WS_H;
    {
        f32x4 s1[8], t[8];
#pragma unroll
        for (int j = 0; j < 8; ++j) { const int col = 4 * lane + 256 * j; s1[j] = *(const f32x4*)(MOD + 1 * 2048 + col) + 1.f; t[j] = *(const f32x4*)(MOD + col); }
        for (int r = gw; r < SEQ; r += 4 * NGW) { f32x4 x[4][8];
#pragma unroll
            for (int k = 0; k < 4; ++k) { const int rk = r + k * NGW; if (rk < SEQ) {
#pragma unroll
                for (int j = 0; j < 8; ++j) x[k][j] = *(const f32x4*)(P.x + (size_t)rk * DM + 4 * lane + 256 * j); } }
#pragma unroll
            for (int k = 0; k < 4; ++k) { const int rk = r + k * NGW; if (rk < SEQ) { unsigned char* hrow = H + (size_t)rk * DM;
#pragma unroll
                for (int j = 0; j < 8; ++j) { const f32x4 h = x[k][j] * s1[j] + t[j]; *(unsigned*)(hrow + 4 * lane + 256 * j) = pack4_fp8(h); } } }
        }
    }
    for (int r = SEQ + gw; r < MROWS; r += NGW) { f32x4 x[8];
#pragma unroll
        for (int j = 0; j < 8; ++j) x[j] = *(const f32x4*)(P.ctx + (size_t)(r - SEQ) * DM + 4 * lane + 256 * j);
        mod_row(x, MOD + (size_t)((0 * 2 + 1) * 3 + 0) * 2048, MOD + (size_t)((0 * 2 + 1) * 3 + 1) * 2048, (bf16_t*)(H + (size_t)r * DM), lane); }
}
__device__ __forceinline__ void ln_one(f32x4 (&v)[8]) {
    float s = 0.f;
#pragma unroll
    for (int j = 0; j < 8; ++j) s += (v[j][0] + v[j][1]) + (v[j][2] + v[j][3]);
    const float mean = wave_sum(s) * (1.f / DM); float q = 0.f;
#pragma unroll
    for (int j = 0; j < 8; ++j) { v[j] = v[j] - mean; q += (v[j][0] * v[j][0] + v[j][1] * v[j][1]) + (v[j][2] * v[j][2] + v[j][3] * v[j][3]); }
    const float rstd = 1.f / sqrtf(wave_sum(q) * (1.f / DM) + LN_EPS);
#pragma unroll
    for (int j = 0; j < 8; ++j) v[j] = v[j] * rstd;
}
__device__ __forceinline__ void phase_ln(const Params& P, int l) {
    const int lane = ltid() & 63, gw = lbid() * 8 + (ltid() >> 6), NGW = gridDim.x * 8;
    const float* MOD = (const float*)(lws(P.ws) + WS_MOD); unsigned char* H = lws(P.ws) + WS_H;   float* X = (float*)(lws(P.ws) + WS_X);
    const float* gam = P.ln_g + l * DM; const float* bet = P.ln_b + l * DM; const bool last = (l == 3);
    {
        const float* sh = MOD + (size_t)(((last ? l : l + 1) * 2 + 0) * 3 + 0) * 2048; const float* sc = sh + 2048;
        f32x4 ga[8], be[8], cur[8], nxt[8];
#pragma unroll
        for (int j = 0; j < 8; ++j) { const int col = 4 * lane + 256 * j; ga[j] = *(const f32x4*)(gam + col); be[j] = *(const f32x4*)(bet + col); }
        int r = gw;
        if (r < SEQ) {
#pragma unroll
            for (int j = 0; j < 8; ++j) cur[j] = *(const f32x4*)(X + (size_t)r * DM + 4 * lane + 256 * j); }
        for (; r < SEQ; r += NGW) { const int rn = r + NGW;
            if (rn < SEQ) {
#pragma unroll
                for (int j = 0; j < 8; ++j) nxt[j] = *(const f32x4*)(X + (size_t)rn * DM + 4 * lane + 256 * j); }
            ln_one(cur);
            float* dst = last ? P.out + (size_t)r * DM : X + (size_t)r * DM; bf16_t* hrow = (bf16_t*)(H + (size_t)r * DM);
#pragma unroll
            for (int j = 0; j < 8; ++j) { const int col = 4 * lane + 256 * j; const f32x4 y = cur[j] * ga[j] + be[j]; *(f32x4*)(dst + col) = y;
                if (!last) { const f32x4 h = y * (*(const f32x4*)(sc + col) + 1.f) + *(const f32x4*)(sh + col); *(unsigned*)((unsigned char*)hrow + col) = pack4_fp8(h); } }
#pragma unroll
            for (int j = 0; j < 8; ++j) cur[j] = nxt[j]; }
    }
    if (!last) for (int r = SEQ + gw; r < MROWS; r += NGW) {
        float* xr = X + (size_t)r * DM; f32x4 v[8]; const float* xsrc = l == 0 ? P.ctx + (size_t)(r - SEQ) * DM : xr;
        const float* part = (const float*)(lws(P.ws) + WS_S) + (size_t)(r - SEQ) * DM; const float* gtc = MOD + (size_t)((l * 2 + 1) * 3 + 2) * 2048;
#pragma unroll
        for (int j = 0; j < 8; ++j) { const int col = 4 * lane + 256 * j; f32x4 a = *(const f32x4*)(part + col);
#pragma unroll
            for (int ks = 1; ks < 4; ++ks) a += *(const f32x4*)(part + (size_t)ks * 256 * 2048 + col);
            v[j] = *(const f32x4*)(xsrc + col) * DN_ALPHA + *(const f32x4*)(gtc + col) * a; }
        ln_one(v);
#pragma unroll
        for (int j = 0; j < 8; ++j) { const int col = 4 * lane + 256 * j; v[j] = v[j] * *(const f32x4*)(gam + col) + *(const f32x4*)(bet + col); *(f32x4*)(xr + col) = v[j]; }
        mod_row(v, MOD + (size_t)(((l + 1) * 2 + 1) * 3 + 0) * 2048, MOD + (size_t)(((l + 1) * 2 + 1) * 3 + 1) * 2048, (bf16_t*)(H + (size_t)r * DM), lane); }
}
__device__ __forceinline__ bool odd_fix_ok(const Params& P, int i, int lane) {
    float mq = fmaxf(fabsf(P.q_norm_g[i * 128 + lane]), fabsf(P.q_norm_g[i * 128 + 64 + lane])), mk = fmaxf(fabsf(P.k_norm_g[i * 128 + lane]), fabsf(P.k_norm_g[i * 128 + 64 + lane]));
#pragma unroll
    for (int o = 1; o < 64; o <<= 1) { mq = fmaxf(mq, __shfl_xor(mq, o)); mk = fmaxf(mk, __shfl_xor(mk, o)); }
    return 11.313708498984761f * mq * mk * 1.02f * 1.4426950408889634f <= 64.f;
}
__device__ __forceinline__ void phase_qknorm(const Params& P, int i) {
    const int lane = ltid() & 63, gw = lbid() * 8 + (ltid() >> 6), NGW = gridDim.x * 8, c = lane & 7, hsub = lane >> 3;
    bf16_t* PB = (bf16_t*)(lws(P.ws) + WS_P);
    float gq1[8], gq2[8], gk1[8], gk2[8], inv[8]; const bool fixok = odd_fix_ok(P, i, lane);
#pragma unroll
    for (int e = 0; e < 8; ++e) { const int d = 8 * c + e; gq1[e] = P.q_norm_g[i * 128 + d]; gq2[e] = P.q_norm_g[i * 128 + 64 + d]; gk1[e] = P.k_norm_g[i * 128 + d]; gk2[e] = P.k_norm_g[i * 128 + 64 + d];
        inv[e] = exp2f(-(float)(d & 31) * (13.287712379549449f / 32.f)) * 0.15915494309189535f; }
    u32x4 av[3], bv[3], an[3], bn[3];
    if (gw < MROWS) {
#pragma unroll
        for (int ps = 0; ps < 3; ++ps) { const int hd = ps * 8 + hsub; if (hd < 20) { av[ps] = *(const u32x4*)(PB + (size_t)gw * LDO + hd * 128 + 8 * c); bv[ps] = *(const u32x4*)(PB + (size_t)gw * LDO + hd * 128 + 64 + 8 * c); } } }
    for (int r = gw; r < MROWS; r += NGW) {
        bf16_t* row = PB + (size_t)r * LDO;
        if (r + NGW < MROWS) { const bf16_t* rn = PB + (size_t)(r + NGW) * LDO;
#pragma unroll
            for (int ps = 0; ps < 3; ++ps) { const int hd = ps * 8 + hsub; if (hd < 20) { an[ps] = *(const u32x4*)(rn + hd * 128 + 8 * c); bn[ps] = *(const u32x4*)(rn + hd * 128 + 64 + 8 * c); } } }
        float cs[8], sn[8];
        if (r < SEQ) { const float pos = (float)(c < 4 ? (r >> 6) : (r & 63));
#pragma unroll
            for (int e = 0; e < 8; ++e) { float rev = pos * inv[e]; rev -= floorf(rev); cs[e] = __builtin_amdgcn_cosf(rev); sn[e] = __builtin_amdgcn_sinf(rev); } }
        else {
#pragma unroll
            for (int e = 0; e < 8; ++e) { cs[e] = 1.f; sn[e] = 0.f; } }
#pragma unroll
        for (int ps = 0; ps < 3; ++ps) { const int hd = ps * 8 + hsub; const bool act = hd < 20;
            float a[8], b[8]; float ss = 0.f;
#pragma unroll
            for (int e = 0; e < 4; ++e) { a[2 * e] = act ? bf_lo(av[ps][e]) : 0.f; a[2 * e + 1] = act ? bf_hi(av[ps][e]) : 0.f; b[2 * e] = act ? bf_lo(bv[ps][e]) : 0.f; b[2 * e + 1] = act ? bf_hi(bv[ps][e]) : 0.f; }
#pragma unroll
            for (int e = 0; e < 8; ++e) ss += a[e] * a[e] + b[e] * b[e];
            ss += __shfl_xor(ss, 1); ss += __shfl_xor(ss, 2); ss += __shfl_xor(ss, 4);
            const float rstd = 1.f / sqrtf(ss * (1.f / 128.f) + RMS_EPS); const bool isq = hd < 16;
            u32x4 oa, ob;
            const float rq = (isq && fixok) ? rstd * (att::SCALE * 1.4426950408889634f) : rstd;
#pragma unroll
            for (int e = 0; e < 4; ++e) { float x0 = a[2 * e] * rq * (isq ? gq1[2 * e] : gk1[2 * e]), x1 = a[2 * e + 1] * rq * (isq ? gq1[2 * e + 1] : gk1[2 * e + 1]);
                float y0 = b[2 * e] * rq * (isq ? gq2[2 * e] : gk2[2 * e]), y1 = b[2 * e + 1] * rq * (isq ? gq2[2 * e + 1] : gk2[2 * e + 1]);
                oa[e] = cvt_pk_bf16(x0 * cs[2 * e] - y0 * sn[2 * e], x1 * cs[2 * e + 1] - y1 * sn[2 * e + 1]);
                ob[e] = cvt_pk_bf16(y0 * cs[2 * e] + x0 * sn[2 * e], y1 * cs[2 * e + 1] + x1 * sn[2 * e + 1]); }
            if (act) { *(u32x4*)(row + hd * 128 + 8 * c) = oa; *(u32x4*)(row + hd * 128 + 64 + 8 * c) = ob; } }
#pragma unroll
        for (int ps = 0; ps < 3; ++ps) { av[ps] = an[ps]; bv[ps] = bn[ps]; }
    }
}

__device__ __forceinline__ void s5_stage_z(const bf16_t* __restrict__ PB, const bf16_t* __restrict__ HBg, unsigned char* ldsB, int g, int cb, int nks, int tid) {
    for (int piece = tid; piece < nks * 64; piece += 512) { const int ks = piece >> 6, ln = piece & 63, r32 = ln & 31, hi = ln >> 5; int bc = cb * 32 + r32; bc = bc < NCHUNK ? bc : NCHUNK - 1;
        const bf16_t* src = ks < 16 ? PB + (size_t)(bc * 16 + ks) * LDE + 4096 + g * 16 + hi * 8 : HBg + (size_t)bc * 256 + (ks - 16) * 16 + hi * 8;
        *(bf16x8*)(ldsB + piece * 16) = *(const bf16x8*)src; }
}
__device__ __forceinline__ void s5_gemm1_item(const bf16_t* __restrict__ PB, const bf16_t* __restrict__ T1g, float* __restrict__ Sg, unsigned char* ldsB, int g, int cb, int tid) {
    const int wid = tid >> 6, lane = tid & 63, r32 = lane & 31, hi = lane >> 5, bc = cb * 32 + r32;
    s5_stage_z(PB, nullptr, ldsB, g, cb, 16, tid);
    __syncthreads();
    f32x16 acc = {};
#pragma unroll
    for (int ks = 0; ks < 16; ++ks) { const bf16x8 a = *(const bf16x8*)(T1g + ((size_t)(wid * 16 + ks) * 64 + lane) * 8), b = *(const bf16x8*)(ldsB + (ks * 64 + lane) * 16); acc = __builtin_amdgcn_mfma_f32_32x32x16_bf16(a, b, acc, 0, 0, 0); }
    if (bc < NCHUNK) {
#pragma unroll
        for (int q = 0; q < 4; ++q) { const f32x4 v = {acc[4 * q], acc[4 * q + 1], acc[4 * q + 2], acc[4 * q + 3]}; *(f32x4*)(Sg + (size_t)bc * 256 + wid * 32 + 8 * q + 4 * hi) = v; } }
    __syncthreads();
}
__device__ __forceinline__ void s5_scan_item(const float* __restrict__ Sg, bf16_t* __restrict__ HBg, const float* __restrict__ LAMg, int dir, float* xl, int tid) {
    const int wid = tid >> 6, lane = tid & 63;
    const float lre = LAMg[(dir * 64 + lane) * 2], lim = LAMg[(dir * 64 + lane) * 2 + 1]; const int off = dir * 128 + lane;
#define S5_BC(n) (dir == 0 ? ((n) < 16 ? 512 + (n) : (n) - 16) : 527 - (n))
    const int n0 = wid * 66;
    float er = 0.f, ei = 0.f, pr = 1.f, pi = 0.f;
    for (int b = 0; b < 6; ++b) { float sr[11], si[11];
#pragma unroll
        for (int k = 0; k < 11; ++k) { const int bc = S5_BC(n0 + b * 11 + k); sr[k] = Sg[(size_t)bc * 256 + off]; si[k] = Sg[(size_t)bc * 256 + off + 64]; }
#pragma unroll
        for (int k = 0; k < 11; ++k) { const float tr = lre * er - lim * ei + sr[k], ti = lre * ei + lim * er + si[k]; er = tr; ei = ti; const float qr = pr * lre - pi * lim, qi = pr * lim + pi * lre; pr = qr; pi = qi; } }
    __syncthreads();
    xl[(wid * 64 + lane) * 2] = er; xl[(wid * 64 + lane) * 2 + 1] = ei;
    __syncthreads();
    float hr = 0.f, hi_ = 0.f;
    for (int w = 0; w < wid; ++w) { const float e0 = xl[(w * 64 + lane) * 2], e1 = xl[(w * 64 + lane) * 2 + 1]; const float tr = pr * hr - pi * hi_ + e0, ti = pr * hi_ + pi * hr + e1; hr = tr; hi_ = ti; }
    for (int b = 0; b < 6; ++b) { float sr[11], si[11];
#pragma unroll
        for (int k = 0; k < 11; ++k) { const int bc = S5_BC(n0 + b * 11 + k); sr[k] = Sg[(size_t)bc * 256 + off]; si[k] = Sg[(size_t)bc * 256 + off + 64]; }
#pragma unroll
        for (int k = 0; k < 11; ++k) { const int bc = S5_BC(n0 + b * 11 + k);
            HBg[(size_t)bc * 256 + off] = f2bf(hr); HBg[(size_t)bc * 256 + off + 64] = f2bf(hi_);
            const float tr = lre * hr - lim * hi_ + sr[k], ti = lre * hi_ + lim * hr + si[k]; hr = tr; hi_ = ti; } }
#undef S5_BC
    __syncthreads();
}
__device__ __forceinline__ void s5_gemm2_item(const bf16_t* __restrict__ PB, const bf16_t* __restrict__ T2g, const bf16_t* __restrict__ HBg, bf16_t* __restrict__ ZB, unsigned char* ldsB, int g, int cb, int tid) {
    const int wid = tid >> 6, lane = tid & 63, r32 = lane & 31, hi = lane >> 5, bc = cb * 32 + r32;
    s5_stage_z(PB, HBg, ldsB, g, cb, 32, tid);
    __syncthreads();
    f32x16 acc = {};
#pragma unroll
    for (int ks = 0; ks < 32; ++ks) { const bf16x8 a = *(const bf16x8*)(T2g + ((size_t)(wid * 32 + ks) * 64 + lane) * 8), b = *(const bf16x8*)(ldsB + (ks * 64 + lane) * 16); acc = __builtin_amdgcn_mfma_f32_32x32x16_bf16(a, b, acc, 0, 0, 0); }
    if (bc < NCHUNK) {
#pragma unroll
        for (int q = 0; q < 4; ++q) { const int t = 2 * wid + (q >> 1), co = (q & 1) * 8 + 4 * hi;
            u32x2 w; w.x = cvt_pk_bf16(gelu_tanh(acc[4 * q]), gelu_tanh(acc[4 * q + 1])); w.y = cvt_pk_bf16(gelu_tanh(acc[4 * q + 2]), gelu_tanh(acc[4 * q + 3]));
#ifdef EXP_ZERO_S5
            w.x = 0u; w.y = 0u;
#endif
            *(u32x2*)(ZB + (size_t)(bc * 16 + t) * 1024 + g * 16 + co) = w; } }
    __syncthreads();
}

template <int NKS>
__device__ __forceinline__ void s5_load_pieces(const bf16_t* __restrict__ PB, const bf16_t* __restrict__ HB, int it, int tid, bf16x8 (&pre)[NKS / 8]) {
    const int g = it / 17, cb = it % 17;
#pragma unroll
    for (int q = 0; q < NKS / 8; ++q) { const int piece = tid + 512 * q, ks = piece >> 6, ln = piece & 63, r32 = ln & 31, hi = ln >> 5; int bc = cb * 32 + r32; bc = bc < NCHUNK ? bc : NCHUNK - 1;
        const bf16_t* src = ks < 16 ? PB + (size_t)(bc * 16 + ks) * LDE + 4096 + g * 16 + hi * 8 : HB + (size_t)g * NCHUNK * 256 + (size_t)bc * 256 + (ks - 16) * 16 + hi * 8;
        pre[q] = *(const bf16x8*)src; }
}
template <int NKS>
__device__ __forceinline__ void s5_gemm_loop(const bf16_t* __restrict__ PB, const bf16_t* __restrict__ Tb, const bf16_t* __restrict__ HB, float* __restrict__ S, bf16_t* __restrict__ ZB, unsigned char* ldsB, int tid, int Gall, int b0) {
    const int wid = tid >> 6, lane = tid & 63, r32 = lane & 31, hi = lane >> 5; constexpr int NIT = 64 * 17; const int G = Gall - b0;
    bf16x8 pre[NKS / 8]; int it = lbid() >= b0 ? lbid() - b0 : NIT;
    if (it < NIT) s5_load_pieces<NKS>(PB, HB, it, tid, pre);
    for (; it < NIT; it += G) {
        const int g = it / 17, cb = it % 17, bc = cb * 32 + r32; const bf16_t* Tg = Tb + (size_t)g * (256 * NKS * 16);
#pragma unroll
        for (int q = 0; q < NKS / 8; ++q) *(bf16x8*)(ldsB + (tid + 512 * q) * 16) = pre[q];
        bf16x8 a[16];
#pragma unroll
        for (int ks = 0; ks < 16; ++ks) a[ks] = *(const bf16x8*)(Tg + ((size_t)(wid * NKS + ks) * 64 + lane) * 8);
        __syncthreads();
        if (it + G < NIT) s5_load_pieces<NKS>(PB, HB, it + G, tid, pre);
        f32x16 acc = {};
#pragma unroll
        for (int ks = 0; ks < 16; ++ks) acc = __builtin_amdgcn_mfma_f32_32x32x16_bf16(a[ks], *(const bf16x8*)(ldsB + (ks * 64 + lane) * 16), acc, 0, 0, 0);
        if constexpr (NKS == 32) {
#pragma unroll
            for (int ks = 0; ks < 16; ++ks) a[ks] = *(const bf16x8*)(Tg + ((size_t)(wid * NKS + 16 + ks) * 64 + lane) * 8);
#pragma unroll
            for (int ks = 0; ks < 16; ++ks) acc = __builtin_amdgcn_mfma_f32_32x32x16_bf16(a[ks], *(const bf16x8*)(ldsB + ((16 + ks) * 64 + lane) * 16), acc, 0, 0, 0);
        }
        if (bc < NCHUNK) {
            if constexpr (NKS == 16) {
#pragma unroll
                for (int q = 0; q < 4; ++q) { const f32x4 v = {acc[4 * q], acc[4 * q + 1], acc[4 * q + 2], acc[4 * q + 3]}; *(f32x4*)(S + (size_t)g * NCHUNK * 256 + (size_t)bc * 256 + wid * 32 + 8 * q + 4 * hi) = v; }
            } else {
#pragma unroll
                for (int q = 0; q < 4; ++q) { const int t = 2 * wid + (q >> 1), co = (q & 1) * 8 + 4 * hi;
                    u32x2 w; w.x = cvt_pk_bf16(gelu_tanh(acc[4 * q]), gelu_tanh(acc[4 * q + 1])); w.y = cvt_pk_bf16(gelu_tanh(acc[4 * q + 2]), gelu_tanh(acc[4 * q + 3]));
                    *(u32x2*)(ZB + (size_t)(bc * 16 + t) * 1024 + g * 16 + co) = w; }
            }
        }
        __syncthreads();
    }
}

__device__ __forceinline__ void phase_attn(const Params& P, int l, unsigned char* lds) {
    const int i = l >> 1; const bool even = (l & 1) == 0, need_ctx = l < 3; const int G = gridDim.x, tid = ltid(), wid = tid >> 6, lane = tid & 63;
    const bf16_t* PB = (const bf16_t*)(lws(P.ws) + WS_P); bf16_t* OG = (bf16_t*)(lws(P.ws) + WS_OG);
    const int ld = even ? LDE : LDO;
    const int nctx = even ? 8 : (need_ctx ? 16 : 0), nitems = even ? nctx : nctx + 512;
#ifndef NO_DENSE
    const float mfixC = 0.f; const bool fixok = !even && odd_fix_ok(P, i, lane);
    for (int it = lbid(); it < nitems; it += G) {
        int h, q0, base, NT;
        if (it < nctx) { h = it; q0 = SEQ; base = SEQ; NT = 4; } else { const int r = it - nctx; h = r >> 5; q0 = (r & 31) * 256; base = 0; NT = MROWS / 64; }
        const int kcol = even ? 1024 + h * 128 : 2048 + (h >> 2) * 128, vcol = even ? 2048 + h * 128 : 2560 + (h >> 2) * 128;
        if (even) att::attn_body<LDE, att::DenseTiles, false>(PB + (size_t)q0 * ld + h * 128, PB + kcol, PB + vcol, PB + (size_t)q0 * ld + 3072 + h * 128, (bf16_t*)((unsigned char*)OG + (size_t)q0 * 2048 + h * 128), NT, att::DenseTiles{base}, (char*)lds, mfixC);
        else if (fixok) att::attn_body<LDO, att::DenseTiles, true>(PB + (size_t)q0 * ld + h * 128, PB + kcol, PB + vcol, PB + (size_t)q0 * ld + 3072 + h * 128, (bf16_t*)((unsigned char*)OG + (size_t)q0 * 2048 + h * 128), NT, att::DenseTiles{base}, (char*)lds, mfixC);
        else att::attn_body<LDO, att::DenseTiles, false>(PB + (size_t)q0 * ld + h * 128, PB + kcol, PB + vcol, PB + (size_t)q0 * ld + 3072 + h * 128, (bf16_t*)((unsigned char*)OG + (size_t)q0 * 2048 + h * 128), NT, att::DenseTiles{base}, (char*)lds, mfixC);
    }
#endif
    if (even) {
        float* rpbS = (float*)(lds + 8 * 16640);
#ifndef NO_NA
        for (int it = lbid(); it < 256; it += G) {
            const int h = it & 7, rb = it >> 3;
            __syncthreads();
            for (int e = tid; e < 465; e += 512) rpbS[e] = P.na_rpb[(size_t)(i * 8 + h) * 465 + e] * (1.f / att::SCALE);
            __syncthreads();
            att::na_wave(PB, OG, rpbS, rb * 4 + (wid >> 1), (wid & 1) * 32, h, (char*)lds + wid * 16640, lane);
        }
        __syncthreads();
#endif
        const bf16_t* T1 = (const bf16_t*)(lws(P.ws) + WS_T1) + (size_t)i * 64 * 256 * 256; float* S = (float*)(lws(P.ws) + WS_S);
        s5_gemm_loop<16>(PB, T1, nullptr, S, nullptr, lds, tid, G, 8);
    }
}

__device__ __forceinline__ void decode_phase(int ph, int& kind, int& l) {
    l = 0;
    if (ph < 3) { kind = ph; return; }
    int r = ph - 3; if (r >= 7) { r -= 7; l = 1; if (r >= 5) { r -= 5; l = 2; if (r >= 7) { r -= 7; l = 3; } } }
    if ((l & 1) == 0) kind = 3 + r; else kind = (r == 0) ? 3 : (r == 1) ? 10 : (r == 2) ? 4 : (r == 3) ? 8 : 9;
}
__device__ __forceinline__ void run_kind(const Params& P, int kind, int l, unsigned char* lds) {
    LAS unsigned char* ldsl = (LAS unsigned char*)lds;
    unsigned char* ws = lws(P.ws); const int G = gridDim.x;
    const int i = l >> 1; const bool even = (l & 1) == 0;
#ifndef PHMASK
#define PHMASK 0xffff
#endif
    if (!((PHMASK >> kind) & 1)) return;
    switch (kind) {
    case 0: phase_prologue(P, ldsl); break;
    case 1: phase_finalize_mod(P); break;
    case 2: phase_mod0(P); break;
    case 3: {
        const int N = even ? EVEN_IN : ODD_IN; const bf16_t* Bt = even ? (const bf16_t*)(ws + WS_WEVIN + (size_t)i * 6144 * 2048) : (const bf16_t*)(ws + WS_WODIN + (size_t)i * 5120 * 2048);
        pg8::Gemm g{(const bf16_t*)(ws + WS_H), Bt, MROWS, N, DM / 2, DM / 2}; pg8::StaticOrder S; S.init(MROWS, N, G, (int)lbid());
        pg8::EpiBf16 E{(bf16_t*)(ws + WS_P), even ? LDE : LDO, 1.f / WIN_SCALE};
        pg8::gemm_phase<pg8::EpiBf16, pg8::StaticOrder, true, true, true>(ldsl, g, S, E);
    } break;
    case 4: phase_attn(P, l, lds); break;
    case 5: {
        for (int it = lbid(); it < 128; it += G) { const int g = it >> 1, dir = it & 1;
            s5_scan_item((const float*)(ws + WS_S) + (size_t)g * NCHUNK * 256, (bf16_t*)(ws + WS_HB) + (size_t)g * NCHUNK * 256, (const float*)(ws + WS_LAM) + (size_t)(i * 64 + g) * 256, dir, (float*)lds, ltid()); }
    } break;
    case 6: {
        const bf16_t* T2 = (const bf16_t*)(ws + WS_T2) + (size_t)i * 64 * 256 * 512;
        s5_gemm_loop<32>((const bf16_t*)(ws + WS_P), T2, (const bf16_t*)(ws + WS_HB), nullptr, (bf16_t*)(ws + WS_ZB), lds, ltid(), G, 0);
    } break;
    case 7: {
        pg8::Gemm g{(const bf16_t*)(ws + WS_ZB), (const bf16_t*)(ws + WS_WGLU) + (size_t)i * 1024 * 1024, MROWS, 1024, 1024, 1024}; pg8::StaticOrder S; S.init(MROWS, 1024, G, (int)lbid());
        pg8::EpiGlu E{(const bf16_t*)(ws + WS_ZB), (const bf16_t*)(ws + WS_P), P.s5_glu_b + i * 1024, (bf16_t*)(ws + WS_OG)};
        pg8::gemm_phase<pg8::EpiGlu, pg8::StaticOrder, true, true>(ldsl, g, S, E);
    } break;
    case 8: {
        const bf16_t* Bt = even ? (const bf16_t*)(ws + WS_WEVOUT + (size_t)i * 2048 * 2048) : (const bf16_t*)(ws + WS_WODOUT + (size_t)i * 2048 * 2048);
        {   pg8::Gemm g{(const bf16_t*)(ws + WS_OG), Bt, SEQ, DM, DM / 2, DM / 2}; pg8::StaticOrder S; S.init(SEQ, DM, G, (int)lbid());
            float* X = (float*)(ws + WS_X); const float* MOD = (const float*)(ws + WS_MOD);
            pg8::EpiOut E{l == 0 ? P.x : X, X, X, MOD + (size_t)((l * 2 + 0) * 3 + 2) * 2048, MOD + (size_t)((l * 2 + 0) * 3 + 2) * 2048, DN_ALPHA, 1.f / (OG_SCALE * WOUT_SCALE)};
            pg8::gemm_phase<pg8::EpiOut, pg8::StaticOrder, true, true, true>(ldsl, g, S, E); }
    } break;
    case 9: phase_ln(P, l); break;
    case 10: phase_qknorm(P, i); break;
    case 11: {
        const unsigned char* Bt = even ? ws + WS_WEVOUT + (size_t)i * 2048 * 2048 : ws + WS_WODOUT + (size_t)i * 2048 * 2048;
        const int b = lbid(), ks = b >> 3;
        pg8::Gemm g{(const bf16_t*)(ws + WS_OG + (size_t)SEQ * DM + ks * 512), (const bf16_t*)(Bt + ks * 512), 256, DM, 256, DM / 2}; pg8::OneUnit S{b & 7, b < 32};
        pg8::EpiPart E{(float*)(ws + WS_S) + (size_t)ks * 256 * 2048, 1.f / (OG_SCALE * WOUT_SCALE)};
        pg8::gemm_phase<pg8::EpiPart, pg8::OneUnit, false, true, true>(ldsl, g, S, E);
    } break;
    case 12: case 13: case 14: case 15: {
        const int b0 = kind == 12 ? 24 : kind == 13 ? 132 : kind == 14 ? 148 : 24;
        if (lbid() >= b0) convert_seg(P, kind - 11, (lbid() - b0) * 8 + (ltid() >> 6), (G - b0) * 8, (LAS float*)(ldsl + (ltid() >> 6) * 16640), ltid() & 63);
    } break;
    default: break;
    }
}

#define RLX_AGENT __ATOMIC_RELAXED, __HIP_MEMORY_SCOPE_AGENT
#define XB_TMO      128
#define XB_XCNT(j)  (256  + 64 * (j))
#define XB_XSUB(j)  (1280 + 64 * (j))
#define XB_XGEN(j)  (2304 + 64 * (j))
#define XB_TOP      3328
#define XB_TOPGEN   3392
#define XCD_BAR_WORDS 3456
#define XB_SPIN_CAP (1u << 18)

__device__ __forceinline__ unsigned xb_ld(unsigned* p)              { return __hip_atomic_load(p, __ATOMIC_RELAXED, __HIP_MEMORY_SCOPE_AGENT); }
__device__ __forceinline__ unsigned xb_add(unsigned* p, unsigned v) { return __hip_atomic_fetch_add(p, v, __ATOMIC_RELAXED, __HIP_MEMORY_SCOPE_AGENT); }
__device__ __forceinline__ unsigned xb_xcc_id() { return (unsigned)__builtin_amdgcn_s_getreg((3 << 11) | 20) & 0xFu; }
#define XB_SPIN(cond, bar) do { unsigned _sp = 0; while (cond) { __builtin_amdgcn_s_sleep(1); \
    if ((++_sp & 255u) == 0u) { if (xb_ld(&(bar)[XB_TMO])) break; if (_sp > XB_SPIN_CAP) { atomicAdd(&(bar)[XB_TMO], 1u); break; } } } } while (0)

struct XcdBarrier {
    unsigned* bar; unsigned x;
    volatile LAS unsigned* st;
};

__device__ __forceinline__ XcdBarrier xcd_barrier_post(unsigned* bar, volatile LAS unsigned* st) {
    XcdBarrier b; b.bar = bar; b.x = xb_xcc_id(); b.st = st;
    if (ltid() == 0) (void)xb_add(&bar[XB_XCNT(b.x)], 1u);
    return b;
}
__device__ __forceinline__ void xcd_barrier_complete(unsigned* bar, unsigned x, unsigned& nloc, unsigned& nx) {
    const unsigned G = gridDim.x * gridDim.y * gridDim.z;
    unsigned sum, cnt, mine, sp = 0u;
    for (;;) {
        sum = 0u; cnt = 0u; mine = 0u;
#pragma unroll
        for (unsigned j = 0; j < 16; ++j) { const unsigned c = xb_ld(&bar[XB_XCNT(j)]); sum += c; cnt += (c > 0u) ? 1u : 0u; mine = (j == x) ? c : mine; }
        if (sum == G) break;
        __builtin_amdgcn_s_sleep(1);
        if ((++sp & 255u) == 0u) { if (xb_ld(&bar[XB_TMO])) break; if (sp > XB_SPIN_CAP) { atomicAdd(&bar[XB_TMO], 1u); break; } }
    }
    nloc = mine > 0u ? mine : 1u; nx = cnt > 0u ? cnt : 1u;
}

__device__ __forceinline__ void xcd_barrier(const XcdBarrier& b) {
    asm volatile("s_waitcnt vmcnt(0)" ::: "memory");
    __syncthreads();
    if (ltid() == 0) {
        unsigned* bar = b.bar;
        __builtin_amdgcn_s_waitcnt(0);
        unsigned nloc = b.st[0], nx = b.st[1];
        if (nloc == 0u) { xcd_barrier_complete(bar, b.x, nloc, nx); b.st[0] = nloc; b.st[1] = nx; }
        const unsigned old = xb_add(&bar[XB_XSUB(b.x)], 1u);
        const unsigned gen = old / nloc;
        if (old + 1u == (gen + 1u) * nloc) {
            __builtin_amdgcn_fence(__ATOMIC_RELEASE, "agent");
            asm volatile("s_waitcnt vmcnt(0)" ::: "memory");
            const unsigned og = xb_add(&bar[XB_TOP], 1u);
            const unsigned tg = og / nx;
            if (og + 1u == (tg + 1u) * nx) xb_add(&bar[XB_TOPGEN], 1u);
            else XB_SPIN(xb_ld(&bar[XB_TOPGEN]) == tg, bar);
            __builtin_amdgcn_fence(__ATOMIC_ACQUIRE, "agent");
            xb_add(&bar[XB_XGEN(b.x)], 1u);
            asm volatile("s_waitcnt vmcnt(0)" ::: "memory");
        } else {
            XB_SPIN(xb_ld(&bar[XB_XGEN(b.x)]) == gen, bar);
            __builtin_amdgcn_fence(__ATOMIC_ACQUIRE, "agent");
            asm volatile("s_waitcnt vmcnt(0)" ::: "memory");
        }
    }
    __syncthreads();
}

__global__ void __launch_bounds__(512, 2) mega_fwd(Params P) {
    extern __shared__ __attribute__((aligned(16))) unsigned char lds[];
    cg::grid_group grid = cg::this_grid();
    volatile LAS unsigned* misc = (volatile LAS unsigned*)((LAS unsigned char*)lds + LDS_BYTES - 64);
    if (threadIdx.x < 16) misc[threadIdx.x] = 0u;
    __syncthreads();
    XcdBarrier bar = xcd_barrier_post((unsigned*)P.ws, misc);
#define GRID_BAR(ph) do { if ((ph) == P.ph_lo) grid.sync(); else xcd_barrier(bar); } while (0)
    for (int ph = P.ph_lo; ph < P.ph_hi; ++ph) {
        int kind, l; decode_phase(ph, kind, l);
        const int kind2 = (kind == 8 && l < 3) ? 11 : (kind == 3 && l == 0) ? 12 : (kind == 7 && l == 0) ? 13 : (kind == 3 && l == 1) ? 14 : (kind == 3 && l == 2) ? 15 : -1;
        const int nsub = kind2 >= 0 ? 2 : 1;
        for (int sub = 0; sub < nsub; ++sub) run_kind(P, sub == 0 ? kind : kind2, l, lds);
        if (ph + 1 < P.ph_hi) GRID_BAR(ph);
    }
}

#ifndef MK_SPLIT
#define MK_SPLIT 0
#endif
extern "C" void kernel_launch(void* const* d_in, const int* in_sizes, int n_in, void* d_out, int out_size, void* d_ws, size_t ws_size, hipStream_t stream) {
    static int grid = 0;
    if (grid == 0) {
        if (n_in != 25 || out_size != SEQ * DM || ws_size < WS_END) { fprintf(stderr, "kernel_launch: unexpected shapes (n_in %d out %d ws %zu)\n", n_in, out_size, ws_size); grid = -1; return; }
        int dev = 0, cus = 0, per_cu = 0;
        hipGetDevice(&dev); hipDeviceGetAttribute(&cus, hipDeviceAttributeMultiprocessorCount, dev);
        if (hipFuncSetAttribute((const void*)mega_fwd, hipFuncAttributeMaxDynamicSharedMemorySize, LDS_BYTES) != hipSuccess) { fprintf(stderr, "kernel_launch: hipFuncSetAttribute failed\n"); grid = -1; return; }
        if (hipOccupancyMaxActiveBlocksPerMultiprocessor(&per_cu, (const void*)mega_fwd, 512, LDS_BYTES) != hipSuccess || per_cu < 1) { fprintf(stderr, "kernel_launch: occupancy query says %d\n", per_cu); grid = -1; return; }
        grid = cus;
        fprintf(stderr, "kernel_launch: grid %d (per_cu %d)\n", grid, per_cu);
    }
    if (grid < 0) return;
    if (hipMemsetAsync(d_ws, 0, 16384, stream) != hipSuccess) { fprintf(stderr, "kernel_launch: memset failed\n"); return; }
    Params p{};
    const float** pp = (const float**)&p;
    for (int k = 0; k < 25; ++k) pp[k] = (const float*)d_in[k];
    p.out = (float*)d_out; p.ws = (unsigned char*)d_ws;
#if MK_SPLIT
    for (int ph = 0; ph < NPH; ++ph) { p.ph_lo = ph; p.ph_hi = ph + 1; void* args[] = {&p};
        hipError_t e = hipLaunchCooperativeKernel((void*)mega_fwd, dim3(grid), dim3(512), args, LDS_BYTES, stream);
        if (e != hipSuccess) { fprintf(stderr, "launch %d failed: %s\n", ph, hipGetErrorString(e)); break; } }
#else
    p.ph_lo = 0; p.ph_hi = NPH; void* args[] = {&p};
    hipError_t e = hipLaunchCooperativeKernel((void*)mega_fwd, dim3(grid), dim3(512), args, LDS_BYTES, stream);
    if (e != hipSuccess) fprintf(stderr, "cooperative launch failed: %s (grid %d)\n", hipGetErrorString(e), grid);
#endif
}
```

```cpp
#include <hip/hip_runtime.h>
#include <hip/hip_cooperative_groups.h>
#include <cstdio>
#include <cstdint>
namespace cg = cooperative_groups;

#define LAS __attribute__((address_space(3)))
typedef unsigned short bf16_t;
typedef short bf16x8 __attribute__((ext_vector_type(8)));
typedef short s16x4 __attribute__((ext_vector_type(4)));
typedef float f32x4 __attribute__((ext_vector_type(4)));
typedef float f32x16 __attribute__((ext_vector_type(16)));
typedef unsigned u32x4 __attribute__((ext_vector_type(4)));
typedef unsigned u32x2 __attribute__((ext_vector_type(2)));

__device__ __forceinline__ unsigned cvt_pk_bf16(float lo, float hi) { unsigned r; asm volatile("v_cvt_pk_bf16_f32 %0, %1, %2" : "=v"(r) : "v"(lo), "v"(hi)); return r; }
__device__ __forceinline__ float bf_lo(unsigned w) { return __uint_as_float(w << 16); }
__device__ __forceinline__ float bf_hi(unsigned w) { return __uint_as_float(w & 0xffff0000u); }
__device__ __forceinline__ float bf2f(bf16_t b) { return __uint_as_float((unsigned)b << 16); }
__device__ __forceinline__ bf16_t f2bf(float f) { return (bf16_t)(cvt_pk_bf16(f, 0.f) & 0xffffu); }
__device__ __forceinline__ unsigned pack4_fp8(f32x4 h) { int w = __builtin_amdgcn_cvt_pk_fp8_f32(h[0], h[1], 0, false); w = __builtin_amdgcn_cvt_pk_fp8_f32(h[2], h[3], w, true); return (unsigned)w; }
__device__ __forceinline__ unsigned pack4_fp8_sat(f32x4 h) {
    h[0] = __builtin_amdgcn_fmed3f(h[0], -448.f, 448.f); h[1] = __builtin_amdgcn_fmed3f(h[1], -448.f, 448.f); h[2] = __builtin_amdgcn_fmed3f(h[2], -448.f, 448.f); h[3] = __builtin_amdgcn_fmed3f(h[3], -448.f, 448.f);
    return pack4_fp8(h); }
__device__ __forceinline__ float sigmoidf_(float v) { return __builtin_amdgcn_rcpf(1.f + __expf(-v)); }
__device__ __forceinline__ float siluf_(float v) { return v * sigmoidf_(v); }
__device__ __forceinline__ float gelu_tanh(float v) { const float z = 0.7978845608028654f * (v + 0.044715f * v * v * v); return v * sigmoidf_(2.f * z); }
__device__ __forceinline__ float wave_sum(float v) {
#pragma unroll
    for (int o = 1; o < 64; o <<= 1) v += __shfl_xor(v, o);
    return v;
}

__device__ __forceinline__ int ltid() { int t = threadIdx.x; asm volatile("" : "+v"(t)); return t; }
__device__ __forceinline__ int lbid() { int b = blockIdx.x; asm volatile("" : "+s"(b)); return b; }
__device__ __forceinline__ unsigned char* lws(unsigned char* w) { asm volatile("" : "+s"(w)); return w; }

constexpr int DM = 2048, SEQ = 8192, CTXL = 256, MROWS = SEQ + CTXL;
constexpr int EVEN_IN = 6144, ODD_IN = 5120;
constexpr int LDE = EVEN_IN + 128, LDO = ODD_IN + 128;
constexpr float DN_ALPHA = 1.6817928305074290f;
constexpr float LN_EPS = 1e-6f, RMS_EPS = 1e-6f;
constexpr float OG_SCALE = 4.f, WIN_SCALE = 32.f, WOUT_SCALE = 64.f;
constexpr int NCHUNK = MROWS / 16;

namespace pg8 {
#define PG8_LAS __attribute__((address_space(3)))
typedef unsigned short bf16_t;
typedef short bf16x8 __attribute__((ext_vector_type(8)));
typedef float f32x4 __attribute__((ext_vector_type(4)));
typedef unsigned u32x4 __attribute__((ext_vector_type(4)));
constexpr int BM = 256, BK = 64, HALF = 128, HTB = HALF * BK * 2  , STAGE_BYTES = 8 * HTB, NXCD = 8, WGM = 8;

__host__ __device__ __forceinline__ int lds_byte(int r, int c) { const int st = (r >> 4) * 2 + (c >> 5), rr = r & 15, cc = c & 31, ob = rr * 64 + cc * 2; return st * 1024 + (ob ^ (((ob >> 9) & 1) << 5)); }
__host__ __device__ __forceinline__ void stage_rc(int b, int& R, int& C) { const int st = b / 1024, sb = b % 1024, swz = sb ^ (((sb >> 9) & 1) << 5); R = (st >> 1) * 16 + swz / 64; C = (st & 1) * 32 + (swz % 64) / 2; }
__host__ __device__ __forceinline__ int perm32(int rho) { const int n = rho >> 4, i = rho & 15; return 8 * (i >> 2) + 4 * n + (i & 3); }

struct Unit { int pm, pn; };
struct Gemm { const bf16_t* A; const bf16_t* Bt; int M, N, K, ld; };

struct StaticOrder {
    int nM, nN, nwg, G, c;
    __host__ __device__ void init(int M, int N, int G_, int c_) { nM = M / BM; nN = N / BM; nwg = nM * nN; G = G_; c = c_; }
    __host__ __device__ bool next(int i, Unit& u) const {
        const long L = (long)i * G + c; if (L >= nwg) return false;
        int wgid = (int)L; { const int q = nwg / NXCD, r = nwg % NXCD, xcd = wgid % NXCD, off = wgid / NXCD; wgid = (xcd < r ? xcd * (q + 1) : r * (q + 1) + (xcd - r) * q) + off; }
        const int nig = WGM * nN, gid = wgid / nig, fm = gid * WGM, gsz = (nM - fm) < WGM ? (nM - fm) : WGM;
        u.pm = fm + ((wgid % nig) % gsz); u.pn = (wgid % nig) / gsz; return true;
    }
    __device__ __forceinline__ void a_ready(const Unit&) const {}
    __device__ __forceinline__ void done(const Unit&) const {}
};

struct EpiBf16 {
    static constexpr bool PERM = true, AFTER_DRAIN = false;
    bf16_t* O; int ldc; float sc;
    __device__ __forceinline__ void operator()(const f32x4 (&acc)[2][2][4][2], const Unit& u, int wr, int wc, int fr, int fq) const {
        asm volatile("" : "+v"(fr), "+v"(fq));
        const int row0 = u.pm * BM + wr * 64 + fr; const int col0 = u.pn * BM + wc * 32 + 8 * fq;
#pragma unroll
        for (int ai = 0; ai < 2; ++ai)
#pragma unroll
            for (int m = 0; m < 4; ++m) { bf16_t* rowp = O + (size_t)(row0 + ai * HALF + m * 16) * ldc + col0;
#pragma unroll
                for (int bj = 0; bj < 2; ++bj) { const f32x4 v0 = acc[ai][bj][m][0] * sc, v1 = acc[ai][bj][m][1] * sc;
                    u32x4 w; w.x = ::cvt_pk_bf16(v0[0], v0[1]); w.y = ::cvt_pk_bf16(v0[2], v0[3]); w.z = ::cvt_pk_bf16(v1[0], v1[1]); w.w = ::cvt_pk_bf16(v1[2], v1[3]);
                    *(u32x4*)(rowp + bj * HALF) = w; } }
    }
};
struct EpiGlu {
    static constexpr bool PERM = true, AFTER_DRAIN = false;
    const bf16_t* ZB; const bf16_t* P; const float* bias; bf16_t* OG;
    __device__ __forceinline__ void operator()(const f32x4 (&acc)[2][2][4][2], const Unit& u, int wr, int wc, int fr, int fq) const {
        asm volatile("" : "+v"(fr), "+v"(fq));
        const int row0 = u.pm * BM + wr * 64 + fr; const int col0 = u.pn * BM + wc * 32 + 8 * fq;
        f32x4 bv[2][2];
#pragma unroll
        for (int bj = 0; bj < 2; ++bj)
#pragma unroll
            for (int n = 0; n < 2; ++n) bv[bj][n] = *(const f32x4*)(bias + col0 + bj * HALF + 4 * n);
#pragma unroll
        for (int ai = 0; ai < 2; ++ai)
#pragma unroll
            for (int m = 0; m < 4; ++m) { const size_t row = (size_t)(row0 + ai * HALF + m * 16);
#pragma unroll
                for (int bj = 0; bj < 2; ++bj) { const int col = col0 + bj * HALF;
                    const u32x4 zw = *(const u32x4*)(ZB + row * 1024 + col); const u32x4 gw = *(const u32x4*)(P + row * LDE + 5120 + col);
                    const f32x4 v0 = acc[ai][bj][m][0] + bv[bj][0], v1 = acc[ai][bj][m][1] + bv[bj][1];
                    float o[8];
#pragma unroll
                    for (int e = 0; e < 4; ++e) { const unsigned z = zw[e], g = gw[e]; const float a0 = e < 2 ? v0[2 * e] : v1[2 * e - 4], a1 = e < 2 ? v0[2 * e + 1] : v1[2 * e - 3];
                        const float g0 = ::bf_lo(g), g1 = ::bf_hi(g);
                        o[2 * e] = ::bf_lo(z) * g0 * __builtin_amdgcn_rcpf((1.f + __expf(-a0)) * (1.f + __expf(-g0))); o[2 * e + 1] = ::bf_hi(z) * g1 * __builtin_amdgcn_rcpf((1.f + __expf(-a1)) * (1.f + __expf(-g1))); }
                    u32x2 w; w.x = ::pack4_fp8_sat((f32x4){o[0], o[1], o[2], o[3]} * OG_SCALE); w.y = ::pack4_fp8_sat((f32x4){o[4], o[5], o[6], o[7]} * OG_SCALE);
                    *(u32x2*)((unsigned char*)OG + row * 2048 + 1024 + col) = w; } }
    }
};
struct EpiOut {
    static constexpr bool PERM = true, AFTER_DRAIN = false;
    const float* srcL; const float* srcC; float* X; const float* gtL; const float* gtC; float alpha, sc;
    __device__ __forceinline__ void operator()(const f32x4 (&acc)[2][2][4][2], const Unit& u, int wr, int wc, int fr, int fq) const {
        asm volatile("" : "+v"(fr), "+v"(fq));
        const int row0 = u.pm * BM + wr * 64 + fr; const int col0 = u.pn * BM + wc * 32 + 8 * fq;
        const float* src = u.pm < 32 ? srcL : srcC; const float* gt = u.pm < 32 ? gtL : gtC;
        f32x4 gv[2][2];
#pragma unroll
        for (int bj = 0; bj < 2; ++bj)
#pragma unroll
            for (int n = 0; n < 2; ++n) gv[bj][n] = *(const f32x4*)(gt + col0 + bj * HALF + 4 * n) * sc;
#pragma unroll
        for (int ai = 0; ai < 2; ++ai)
#pragma unroll
            for (int m = 0; m < 4; ++m) { const size_t off = (size_t)(row0 + ai * HALF + m * 16) * 2048 + col0;
#pragma unroll
                for (int bj = 0; bj < 2; ++bj)
#pragma unroll
                    for (int n = 0; n < 2; ++n) { const f32x4 xs = *(const f32x4*)(src + off + bj * HALF + 4 * n);
                        *(f32x4*)(X + off + bj * HALF + 4 * n) = xs * alpha + gv[bj][n] * acc[ai][bj][m][n]; } }
    }
};

struct EpiPart {
    static constexpr bool PERM = true, AFTER_DRAIN = false;
    float* O; float sc;
    __device__ __forceinline__ void operator()(const f32x4 (&acc)[2][2][4][2], const Unit& u, int wr, int wc, int fr, int fq) const {
        asm volatile("" : "+v"(fr), "+v"(fq));
        const int row0 = u.pm * BM + wr * 64 + fr; const int col0 = u.pn * BM + wc * 32 + 8 * fq;
#pragma unroll
        for (int ai = 0; ai < 2; ++ai)
#pragma unroll
            for (int m = 0; m < 4; ++m) { const size_t off = (size_t)(row0 + ai * HALF + m * 16) * 2048 + col0;
#pragma unroll
                for (int bj = 0; bj < 2; ++bj)
#pragma unroll
                    for (int n = 0; n < 2; ++n) *(f32x4*)(O + off + bj * HALF + 4 * n) = acc[ai][bj][m][n] * sc; }
    }
};
struct OneUnit { int pn; bool valid;
    __device__ __forceinline__ bool next(int i, Unit& u) const { u.pm = 0; u.pn = pn; return i == 0 && valid; }
    __device__ __forceinline__ void a_ready(const Unit&) const {}
    __device__ __forceinline__ void done(const Unit&) const {}
};

template <class Epi, class Sched, bool ALIGN_EPI = false, bool SP2 = false, bool FP8 = false>
__device__ __forceinline__ void gemm_phase(PG8_LAS unsigned char* lds, const Gemm g, const Sched& S, const Epi& E) {
    const int tid = ltid(), wid = __builtin_amdgcn_readfirstlane(tid >> 6), lane = tid & 63, wr = wid >> 2, wc = wid & 3, fr = lane & 15, fq = lane >> 4;
    const int K = g.K, nt = K / BK;
    unsigned voffA[2], voffB[2];
#pragma unroll
    for (int i = 0; i < 2; ++i) { int R, C; stage_rc(tid * 16 + i * 8192, R, C); const int Rb = Epi::PERM ? ((R & ~31) + perm32(R & 31)) : R;
        voffA[i] = (unsigned)(R * g.ld + C) * 2u; voffB[i] = (unsigned)(Rb * g.ld + C) * 2u; }
    const size_t kstep = (size_t)(BK * 2);
    const size_t hstep = (size_t)HALF * g.ld * 2;
    const size_t tstep = 2 * hstep;
    const unsigned ldsw = (unsigned)wid * 1024u;
    const int aoff = lds_byte(wr * 64 + fr, fq * 8), boff = lds_byte(wc * 32 + fr, fq * 8);
#define PG8_SA(b, h) (((b) * 2 + (h)) * HTB)
#define PG8_SB(b, h) ((4 + (b) * 2 + (h)) * HTB)
#define PG8_STAGE(bufoff, gbase, voff) do { _Pragma("unroll") for (int _i = 0; _i < 2; ++_i) \
        __builtin_amdgcn_global_load_lds((const unsigned*)((const char*)(gbase) + (voff)[_i]), (PG8_LAS unsigned*)(lds + (bufoff) + ldsw + _i * 8192), 16, 0, 0); } while (0)
#define PG8_LDA(dst, b, h) do { if constexpr (FP8) { _Pragma("unroll") for (int m = 0; m < 4; ++m) dst##8[m] = __builtin_shufflevector(*(const PG8_LAS i32x4_*)(lds + PG8_SA(b, h) + aoff + m * 2048), *(const PG8_LAS i32x4_*)(lds + PG8_SA(b, h) + aoff + m * 2048 + 1024), 0, 1, 2, 3, 4, 5, 6, 7); } \
        else { _Pragma("unroll") for (int m = 0; m < 4; ++m) _Pragma("unroll") for (int k = 0; k < 2; ++k) dst[m][k] = *(const PG8_LAS bf16x8*)(lds + PG8_SA(b, h) + aoff + m * 2048 + k * 1024); } } while (0)
#define PG8_LDB(dst, b, h) do { if constexpr (FP8) { _Pragma("unroll") for (int n = 0; n < 2; ++n) dst##8[n] = __builtin_shufflevector(*(const PG8_LAS i32x4_*)(lds + PG8_SB(b, h) + boff + n * 2048), *(const PG8_LAS i32x4_*)(lds + PG8_SB(b, h) + boff + n * 2048 + 1024), 0, 1, 2, 3, 4, 5, 6, 7); } \
        else { _Pragma("unroll") for (int n = 0; n < 2; ++n) _Pragma("unroll") for (int k = 0; k < 2; ++k) dst[n][k] = *(const PG8_LAS bf16x8*)(lds + PG8_SB(b, h) + boff + n * 2048 + k * 1024); } } while (0)
#define PG8_MMA(ai, bj, At, Bt) do { __builtin_amdgcn_s_setprio(1); _Pragma("unroll") for (int m = 0; m < 4; ++m) _Pragma("unroll") for (int n = 0; n < 2; ++n) { \
        if constexpr (FP8) asm volatile("v_mfma_scale_f32_16x16x128_f8f6f4 %0, %1, %2, %0, %3, %3 op_sel_hi:[0,0,0]" : "+v"(acc[ai][bj][m][n]) : "v"(Bt##8[n]), "v"(At##8[m]), "v"(one_scale)); \
        else { _Pragma("unroll") for (int k = 0; k < 2; ++k) acc[ai][bj][m][n] = __builtin_amdgcn_mfma_f32_16x16x32_bf16(Bt[n][k], At[m][k], acc[ai][bj][m][n], 0, 0, 0); } } \
        __builtin_amdgcn_s_setprio(0); } while (0)
#define PG8_WAIT_V(n) asm volatile("s_waitcnt vmcnt(" #n ")" ::: "memory")
#define PG8_WAIT_L(n) asm volatile("s_waitcnt lgkmcnt(" #n ")" ::: "memory")
#define PG8_BAR __builtin_amdgcn_s_barrier()
#define PG8_SCHED __builtin_amdgcn_sched_barrier(0)
    Unit cur, nxt; int ui = 0;
    if (!S.next(0, cur)) return;
    f32x4 acc[2][2][4][2];
#pragma unroll
    for (int a = 0; a < 2; ++a)
#pragma unroll
        for (int b = 0; b < 2; ++b)
#pragma unroll
            for (int m = 0; m < 4; ++m)
#pragma unroll
                for (int n = 0; n < 2; ++n) acc[a][b][m][n] = (f32x4){0.f, 0.f, 0.f, 0.f};
    typedef int i32x4_ __attribute__((ext_vector_type(4))); typedef int i32x8_ __attribute__((ext_vector_type(8)));
    bf16x8 At[4][2], B0[2][2], B1[2][2]; i32x8_ At8[4], B08[2], B18[2]; const int one_scale = 0x7F7F7F7F;
    const char* cA = (const char*)g.A + (size_t)cur.pm * tstep; const char* cB = (const char*)g.Bt + (size_t)cur.pn * tstep;
    S.a_ready(cur);
    if constexpr (SP2) {
        PG8_STAGE(PG8_SB(0, 0), cB, voffB); PG8_STAGE(PG8_SB(0, 1), cB + hstep, voffB); PG8_STAGE(PG8_SA(0, 0), cA, voffA); PG8_STAGE(PG8_SA(0, 1), cA + hstep, voffA);
        if (wr == 1) PG8_BAR;
        PG8_WAIT_V(2); PG8_BAR;
        PG8_STAGE(PG8_SB(1, 0), cB + kstep, voffB); PG8_STAGE(PG8_SA(1, 0), cA + kstep, voffA); PG8_STAGE(PG8_SB(1, 1), cB + hstep + kstep, voffB);
        PG8_WAIT_V(6); PG8_BAR;
    } else {
        PG8_STAGE(PG8_SB(0, 0), cB, voffB); PG8_STAGE(PG8_SA(0, 0), cA, voffA); PG8_STAGE(PG8_SB(0, 1), cB + hstep, voffB); PG8_STAGE(PG8_SA(0, 1), cA + hstep, voffA);
        if (wr == 1) PG8_BAR;
        PG8_WAIT_V(4); PG8_BAR;
        PG8_STAGE(PG8_SB(1, 0), cB + kstep, voffB); PG8_STAGE(PG8_SA(1, 0), cA + kstep, voffA); PG8_STAGE(PG8_SB(1, 1), cB + hstep + kstep, voffB);
        PG8_WAIT_V(6); PG8_BAR;
    }
    for (;;) {
        const bool has_next = S.next(ui + 1, nxt);
        const char* nA = has_next ? (const char*)g.A + (size_t)nxt.pm * tstep : cA; const char* nB = has_next ? (const char*)g.Bt + (size_t)nxt.pn * tstep : cB;
        for (int t = 0; t < nt; t += 2) {
            const bool last = (t == nt - 2);
            const char* a1 = cA + (size_t)(t + 1) * kstep;
            const char* a2 = last ? nA : cA + (size_t)(t + 2) * kstep; const char* b2 = last ? nB : cB + (size_t)(t + 2) * kstep;
            const char* a3 = a2 + kstep; const char* b3 = b2 + kstep;
            if (last && has_next) S.a_ready(nxt);
            if constexpr (SP2) {
            PG8_LDB(B0, 0, 0); PG8_LDB(B1, 0, 1); PG8_SCHED; PG8_LDA(At, 0, 0); PG8_STAGE(PG8_SA(1, 1), a1 + hstep, voffA);
            PG8_WAIT_V(8); PG8_WAIT_L(0); PG8_BAR; PG8_MMA(0, 0, At, B0); PG8_MMA(0, 1, At, B1); PG8_BAR; PG8_SCHED;
            PG8_LDA(At, 0, 1); PG8_STAGE(PG8_SB(0, 0), b2, voffB); PG8_STAGE(PG8_SB(0, 1), b2 + hstep, voffB); PG8_STAGE(PG8_SA(0, 0), a2, voffA);
            PG8_WAIT_V(8); PG8_WAIT_L(0); PG8_BAR; PG8_MMA(1, 0, At, B0); PG8_MMA(1, 1, At, B1); PG8_BAR; PG8_SCHED;
            PG8_LDB(B0, 1, 0); PG8_LDB(B1, 1, 1); PG8_SCHED; PG8_LDA(At, 1, 0); PG8_STAGE(PG8_SA(0, 1), a2 + hstep, voffA);
            PG8_WAIT_V(8); PG8_WAIT_L(0); PG8_BAR; PG8_MMA(0, 0, At, B0); PG8_MMA(0, 1, At, B1); PG8_BAR; PG8_SCHED;
            PG8_LDA(At, 1, 1); PG8_STAGE(PG8_SB(1, 0), b3, voffB); PG8_STAGE(PG8_SB(1, 1), b3 + hstep, voffB); PG8_STAGE(PG8_SA(1, 0), a3, voffA);
            PG8_WAIT_V(8); PG8_WAIT_L(0); PG8_BAR; PG8_MMA(1, 0, At, B0); PG8_MMA(1, 1, At, B1); PG8_BAR; PG8_SCHED;
            } else {
            PG8_LDB(B0, 0, 0); PG8_SCHED; PG8_LDA(At, 0, 0); PG8_STAGE(PG8_SA(1, 1), a1 + hstep, voffA);
            PG8_WAIT_L(8); PG8_BAR; PG8_WAIT_L(0); PG8_MMA(0, 0, At, B0); PG8_BAR; PG8_SCHED;
            PG8_LDB(B1, 0, 1); PG8_STAGE(PG8_SB(0, 0), b2, voffB);
            PG8_BAR; PG8_WAIT_L(0); PG8_MMA(0, 1, At, B1); PG8_BAR;
            PG8_LDA(At, 0, 1); PG8_STAGE(PG8_SA(0, 0), a2, voffA);
            PG8_BAR; PG8_WAIT_L(0); PG8_MMA(1, 0, At, B0); PG8_BAR; PG8_SCHED;
            PG8_STAGE(PG8_SB(0, 1), b2 + hstep, voffB);
            PG8_WAIT_V(6); PG8_BAR; PG8_MMA(1, 1, At, B1); PG8_BAR;
            PG8_LDB(B0, 1, 0); PG8_SCHED; PG8_LDA(At, 1, 0); PG8_STAGE(PG8_SA(0, 1), a2 + hstep, voffA);
            PG8_WAIT_L(8); PG8_BAR; PG8_WAIT_L(0); PG8_MMA(0, 0, At, B0); PG8_BAR; PG8_SCHED;
            PG8_LDB(B1, 1, 1); PG8_STAGE(PG8_SB(1, 0), b3, voffB);
            PG8_BAR; PG8_WAIT_L(0); PG8_MMA(0, 1, At, B1); PG8_BAR;
            PG8_LDA(At, 1, 1); PG8_STAGE(PG8_SA(1, 0), a3, voffA);
            PG8_BAR; PG8_WAIT_L(0); PG8_MMA(1, 0, At, B0); PG8_BAR; PG8_SCHED;
            PG8_STAGE(PG8_SB(1, 1), b3 + hstep, voffB);
            PG8_WAIT_V(6); PG8_BAR; PG8_MMA(1, 1, At, B1); PG8_BAR;
            }
        }
        if constexpr (ALIGN_EPI) { if (wr == 0) PG8_BAR; }
        if constexpr (!Epi::AFTER_DRAIN) { E(acc, cur, wr, wc, fr, fq); S.done(cur); }
        if (!has_next) break;
#pragma unroll
        for (int a = 0; a < 2; ++a)
#pragma unroll
            for (int b = 0; b < 2; ++b)
#pragma unroll
                for (int m = 0; m < 4; ++m)
#pragma unroll
                    for (int n = 0; n < 2; ++n) acc[a][b][m][n] = (f32x4){0.f, 0.f, 0.f, 0.f};
        cur = nxt; cA = nA; cB = nB; ++ui;
        if constexpr (ALIGN_EPI) { if (wr == 1) PG8_BAR; }
    }
    PG8_WAIT_V(0);
    if constexpr (!ALIGN_EPI) { if (wr == 0) PG8_BAR; }
    PG8_BAR;
    if constexpr (Epi::AFTER_DRAIN) { E.fused(acc, cur, wr, wc, fr, fq, lds, wid, lane); S.done(cur); }
#undef PG8_SA
#undef PG8_SB
#undef PG8_STAGE
#undef PG8_LDA
#undef PG8_LDB
#undef PG8_MMA
#undef PG8_WAIT_V
#undef PG8_WAIT_L
#undef PG8_BAR
#undef PG8_SCHED
}
}
namespace att {
using bf16 = unsigned short;
constexpr int   D = 128, NW = 8, QBLK = 32, KVBLK = 64;
constexpr float SCALE = 0.088388347648318440f;
#ifndef ATT_THR
#define ATT_THR 8.f
#endif
constexpr float THR = ATT_THR;
#ifndef ATT_SDEPTH
#define ATT_SDEPTH 1
#endif
constexpr int SDEPTH = ATT_SDEPTH;
constexpr size_t SHM_V = KVBLK * D * 2, SHM_K = KVBLK * D * 2, SHM_ATTN = 2 * SHM_V + 2 * SHM_K + NW * 64 * 4;
using bf16x8 = __attribute__((ext_vector_type(8))) short;
using s16x4  = __attribute__((ext_vector_type(4))) short;
using f32x16 = __attribute__((ext_vector_type(16))) float;
using f32x8  = __attribute__((ext_vector_type(8))) float;
using u32x4  = __attribute__((ext_vector_type(4))) unsigned;
#define KSWZ(row, colB) ((row) * 256 + ((colB) ^ (((row) & 7) << 4)))
#define SBAR() __builtin_amdgcn_sched_barrier(0)
__device__ __forceinline__ int crow(int r, int hi) { return (r & 3) + 8 * (r >> 2) + 4 * hi; }
__device__ __forceinline__ unsigned cvtpk(float lo, float hi) {
  unsigned r; asm volatile("v_cvt_pk_bf16_f32 %0, %1, %2" : "=v"(r) : "v"(lo), "v"(hi)); return r;
}
template <typename TIn> struct Stage;
template <> struct Stage<bf16>  { using T = bf16x8;
  __device__ static __forceinline__ T ld8(const bf16* p) { return *reinterpret_cast<const bf16x8*>(p); }
  __device__ static __forceinline__ bf16x8 tobf(T x) { return x; } };
template <> struct Stage<float> { using T = f32x8;
  __device__ static __forceinline__ T ld8(const float* p) { return *reinterpret_cast<const f32x8*>(p); }
  __device__ static __forceinline__ bf16x8 tobf(T x) {
    u32x4 w = {cvtpk(x[0], x[1]), cvtpk(x[2], x[3]), cvtpk(x[4], x[5]), cvtpk(x[6], x[7])}; return *reinterpret_cast<bf16x8*>(&w); } };

__device__ __forceinline__ void partialSM(f32x16& p0, f32x16& p1, float& m_reg, float& mn, float& alpha) {
  constexpr float C = SCALE * 1.4426950408889634f;
  float pmax = p0[0]; for (int r = 1; r < 16; ++r) pmax = fmaxf(pmax, p0[r]); for (int r = 0; r < 16; ++r) pmax = fmaxf(pmax, p1[r]);
  { auto rr = __builtin_amdgcn_permlane32_swap(__float_as_uint(pmax), __float_as_uint(pmax), false, false);
    pmax = fmaxf(__uint_as_float(rr[0]), __uint_as_float(rr[1])); }
  if (__builtin_expect(__all(pmax - m_reg <= THR / SCALE), 1)) { mn = m_reg; alpha = 1.f; }
  else { mn = fmaxf(m_reg, pmax); alpha = __builtin_amdgcn_exp2f((m_reg - mn) * C); m_reg = mn; }
  float mnC = -mn * C;
  for (int r = 0; r < 16; ++r) p0[r] = fmaf(p0[r], C, mnC); for (int r = 0; r < 16; ++r) p1[r] = fmaf(p1[r], C, mnC);
  for (int r = 0; r < 16; ++r) p0[r] = __builtin_amdgcn_exp2f(p0[r]);
}
__device__ __forceinline__ void finishSM(f32x16& p0, f32x16& p1, float alpha, float& l_reg, bf16x8& pa0, bf16x8& pa1, bf16x8& pa2, bf16x8& pa3) {
  for (int r = 0; r < 16; ++r) p1[r] = __builtin_amdgcn_exp2f(p1[r]);
  float ps = 0; for (int r = 0; r < 16; ++r) ps += p0[r]; for (int r = 0; r < 16; ++r) ps += p1[r];
  { auto rr = __builtin_amdgcn_permlane32_swap(__float_as_uint(ps), __float_as_uint(ps), false, false);
    ps = __uint_as_float(rr[0]) + __uint_as_float(rr[1]); }
  l_reg = l_reg * alpha + ps;
#define PK4(P, BASE, OUT) do { unsigned a0 = cvtpk(P[BASE + 0], P[BASE + 1]), a1 = cvtpk(P[BASE + 2], P[BASE + 3]);   \
    unsigned b0 = cvtpk(P[BASE + 4], P[BASE + 5]), b1 = cvtpk(P[BASE + 6], P[BASE + 7]);                              \
    auto r0 = __builtin_amdgcn_permlane32_swap(a0, b0, false, false); auto r1 = __builtin_amdgcn_permlane32_swap(a1, b1, false, false); \
    u32x4 w = {r0[0], r1[0], r0[1], r1[1]}; OUT = *reinterpret_cast<bf16x8*>(&w); } while (0)
  PK4(p0, 0, pa0); PK4(p0, 8, pa1); PK4(p1, 0, pa2); PK4(p1, 8, pa3);
#undef PK4
}
__device__ __forceinline__ void qkt(f32x16& p0, f32x16& p1, const bf16* Ks, const bf16x8* qr, int r32, int hi) {
  p0 = f32x16{}; p1 = f32x16{};
  for (int d0 = 0; d0 < 8; ++d0) { int cb = (d0 * 16 + hi * 8) * 2;
    bf16x8 b0 = *reinterpret_cast<const bf16x8*>((const char*)Ks + KSWZ(r32, cb));
    bf16x8 b1 = *reinterpret_cast<const bf16x8*>((const char*)Ks + KSWZ(32 + r32, cb));
    p0 = __builtin_amdgcn_mfma_f32_32x32x16_bf16(b0, qr[d0], p0, 0, 0, 0);
    p1 = __builtin_amdgcn_mfma_f32_32x32x16_bf16(b1, qr[d0], p1, 0, 0, 0); }
}
__device__ __forceinline__ int v_st(int k, int c) { const int kk = (k & ~0xC) | ((k & 4) << 1) | ((k & 8) >> 1); return ((kk >> 3) * 4 + (c >> 5)) * 512 + ((kk & 7) * 32 + (c & 31)) * 2; }
__device__ __forceinline__ int v_rd_base(int lane) { return ((lane & 3) << 3) | (((lane >> 2) & 3) << 6) | (((lane >> 4) & 1) << 5) | (((lane >> 5) & 1) << 8); }
constexpr int v_rd_off(int d0, int ks, int half) { return d0 * 512 + ks * 4096 + half * 2048; }
template <int OFF> __device__ __forceinline__ s16x4 tr_read(int vb) {
  s16x4 r; asm volatile("ds_read_b64_tr_b16 %0, %1 offset:%2" : "=&v"(r) : "v"(vb), "i"(OFF) : "memory"); return r;
}
template <int D0> __device__ __forceinline__ void pv_one(f32x16& od, int vb, bf16x8 pa0, bf16x8 pa1, bf16x8 pa2, bf16x8 pa3) {
  const s16x4 l0 = tr_read<v_rd_off(D0, 0, 0)>(vb), h0 = tr_read<v_rd_off(D0, 0, 1)>(vb), l1 = tr_read<v_rd_off(D0, 1, 0)>(vb), h1 = tr_read<v_rd_off(D0, 1, 1)>(vb);
  const s16x4 l2 = tr_read<v_rd_off(D0, 2, 0)>(vb), h2 = tr_read<v_rd_off(D0, 2, 1)>(vb), l3 = tr_read<v_rd_off(D0, 3, 0)>(vb), h3 = tr_read<v_rd_off(D0, 3, 1)>(vb);
  asm volatile("s_waitcnt lgkmcnt(0)" ::: "memory"); SBAR();
#define PK(L, H) (bf16x8){L[0], L[1], L[2], L[3], H[0], H[1], H[2], H[3]}
  od = __builtin_amdgcn_mfma_f32_32x32x16_bf16(pa0, PK(l0, h0), od, 0, 0, 0);
  od = __builtin_amdgcn_mfma_f32_32x32x16_bf16(pa1, PK(l1, h1), od, 0, 0, 0);
  od = __builtin_amdgcn_mfma_f32_32x32x16_bf16(pa2, PK(l2, h2), od, 0, 0, 0);
  od = __builtin_amdgcn_mfma_f32_32x32x16_bf16(pa3, PK(l3, h3), od, 0, 0, 0);
#undef PK
}
__device__ __forceinline__ void pv_d0(f32x16* o, int vb, bf16x8 pa0, bf16x8 pa1, bf16x8 pa2, bf16x8 pa3) {
  pv_one<0>(o[0], vb, pa0, pa1, pa2, pa3); pv_one<1>(o[1], vb, pa0, pa1, pa2, pa3); pv_one<2>(o[2], vb, pa0, pa1, pa2, pa3); pv_one<3>(o[3], vb, pa0, pa1, pa2, pa3);
}
struct DenseTiles { int base;
  __device__ __forceinline__ int krow(int j) const { return base + j * KVBLK; }
  __device__ __forceinline__ void mask(f32x16&, f32x16&, int, int, int, int) const {} };
__device__ __forceinline__ void partialSM_fix(f32x16& p0, f32x16& p1, float mfixC) {
#pragma unroll
  for (int r = 0; r < 16; ++r) p0[r] = __builtin_amdgcn_exp2f(p0[r]);
}
template <int ld, class TF, bool FIX>
__device__ __forceinline__ void attn_body(const bf16* __restrict__ Qb, const bf16* __restrict__ Kh, const bf16* __restrict__ Vh, const bf16* __restrict__ Gb,
                                          bf16* __restrict__ Ob, int NT, const TF& T, char* lds, float mfixC) {
  using St = Stage<bf16>;
  const int tid = ltid(), wid = tid >> 6, lane = tid & 63, r32 = lane & 31, hi = lane >> 5;
  bf16* V_lds = (bf16*)lds; bf16* K_lds = (bf16*)(lds + 2 * SHM_V);
  float* ws = (float*)(lds + 2 * SHM_V + 2 * SHM_K) + wid * 64; float* li_l = ws; float* al_l = ws + 32;
  float m_reg = -1e30f, l_reg = 0; f32x16 o[4] = {}; bf16x8 qr[8];
  const bf16* Qw = Qb + (long)(wid * QBLK + r32) * ld + hi * 8;
#pragma unroll
  for (int d0 = 0; d0 < 8; ++d0) qr[d0] = St::ld8(Qw + d0 * 16);
  const int sr = tid >> 4, sc = (tid & 15) * 8, vst0 = v_st(sr, sc), vst1 = v_st(32 + sr, sc);
  const int vb0 = (int)(uintptr_t)V_lds + v_rd_base(lane);
  struct { typename St::T vs0, vs1, ks0, ks1; } sr_[SDEPTH];
#define SLOAD(i, k0) do { const long _k0 = (k0); sr_[i].vs0 = St::ld8(&Vh[(_k0 + sr) * ld + sc]); sr_[i].vs1 = St::ld8(&Vh[(_k0 + 32 + sr) * ld + sc]); \
    sr_[i].ks0 = St::ld8(&Kh[(_k0 + sr) * ld + sc]); sr_[i].ks1 = St::ld8(&Kh[(_k0 + 32 + sr) * ld + sc]); } while (0)
#define SWRITE(b, i) do { *(bf16x8*)((char*)V_lds + (b) * SHM_V + vst0) = St::tobf(sr_[i].vs0);          \
    *(bf16x8*)((char*)V_lds + (b) * SHM_V + vst1) = St::tobf(sr_[i].vs1); int kc = sc * 2;               \
    *(bf16x8*)((char*)K_lds + (b) * SHM_K + KSWZ(sr, kc)) = St::tobf(sr_[i].ks0);                       \
    *(bf16x8*)((char*)K_lds + (b) * SHM_K + KSWZ(32 + sr, kc)) = St::tobf(sr_[i].ks1); } while (0)
#define SWAIT() do { if constexpr (SDEPTH == 2) asm volatile("s_waitcnt vmcnt(4)" ::: "memory"); else asm volatile("s_waitcnt vmcnt(0)" ::: "memory"); } while (0)
#define RESC(a) do { if (__any((a) < 1.f)) { if (hi == 0) al_l[r32] = (a); asm volatile("s_waitcnt lgkmcnt(0)" ::: "memory"); \
    for (int d = 0; d < 4; ++d) for (int r = 0; r < 16; ++r) o[d][r] *= al_l[crow(r, hi)]; } } while (0)
  f32x16 pA0, pA1, pB0, pB1; float mnA, mnB, alA, alB; bf16x8 pa0, pa1, pa2, pa3;
  constexpr int SE = 0, SO = SDEPTH - 1;
  SLOAD(SE, T.krow(0)); asm volatile("s_waitcnt vmcnt(0)" ::: "memory"); SWRITE(0, SE); __syncthreads();
  qkt(pA0, pA1, K_lds, qr, r32, hi); T.mask(pA0, pA1, 0, wid, r32, hi); if constexpr (FIX) { partialSM_fix(pA0, pA1, mfixC); alA = 1.f; } else partialSM(pA0, pA1, m_reg, mnA, alA);
  SLOAD(SO, T.krow(1)); if constexpr (SDEPTH == 2) { if (2 < NT) SLOAD(SE, T.krow(2)); }
  SWAIT(); SWRITE(1, SO); __syncthreads();
  for (int j = 1; j + 1 < NT; j += 2) {
    SBAR(); qkt(pB0, pB1, (bf16*)((char*)K_lds + SHM_K), qr, r32, hi); T.mask(pB0, pB1, j, wid, r32, hi);
    finishSM(pA0, pA1, alA, l_reg, pa0, pa1, pa2, pa3); SBAR();
    SLOAD(SO, T.krow(j + SDEPTH)); SBAR();
    pv_d0(o, vb0, pa0, pa1, pa2, pa3); if constexpr (FIX) { partialSM_fix(pB0, pB1, mfixC); alB = 1.f; } else partialSM(pB0, pB1, m_reg, mnB, alB);
    __syncthreads(); SWAIT(); SWRITE(0, SE);
    if constexpr (!FIX) RESC(alB); __syncthreads();
    SBAR(); qkt(pA0, pA1, K_lds, qr, r32, hi); T.mask(pA0, pA1, j + 1, wid, r32, hi);
    finishSM(pB0, pB1, alB, l_reg, pa0, pa1, pa2, pa3); SBAR();
    if (SDEPTH == 1 || j + 3 < NT) SLOAD(SE, T.krow(j + 1 + SDEPTH)); SBAR();
    pv_d0(o, vb0 + (int)SHM_V, pa0, pa1, pa2, pa3); if constexpr (FIX) { partialSM_fix(pA0, pA1, mfixC); alA = 1.f; } else partialSM(pA0, pA1, m_reg, mnA, alA);
    __syncthreads(); SWAIT(); SWRITE(1, SO);
    if constexpr (!FIX) RESC(alA); __syncthreads();
  }
  SBAR(); qkt(pB0, pB1, (bf16*)((char*)K_lds + SHM_K), qr, r32, hi); T.mask(pB0, pB1, NT - 1, wid, r32, hi);
  finishSM(pA0, pA1, alA, l_reg, pa0, pa1, pa2, pa3); SBAR();
  pv_d0(o, vb0, pa0, pa1, pa2, pa3); if constexpr (FIX) { partialSM_fix(pB0, pB1, mfixC); alB = 1.f; } else partialSM(pB0, pB1, m_reg, mnB, alB);
  __syncthreads(); if constexpr (!FIX) RESC(alB);
  finishSM(pB0, pB1, alB, l_reg, pa0, pa1, pa2, pa3); SBAR();
  pv_d0(o, vb0 + (int)SHM_V, pa0, pa1, pa2, pa3);
  if (hi == 0) li_l[r32] = l_reg; asm volatile("s_waitcnt lgkmcnt(0)" ::: "memory");
  float rli[16];
#pragma unroll
  for (int r = 0; r < 16; ++r) rli[r] = __builtin_amdgcn_rcpf(li_l[crow(r, hi)]);
  __syncthreads();
  bf16* ot = (bf16*)lds + wid * (32 * 136);
#pragma unroll
  for (int r = 0; r < 16; ++r) { const int orow = crow(r, hi);
#pragma unroll
    for (int d0 = 0; d0 < 4; ++d0) ot[orow * 136 + d0 * 32 + r32] = ::f2bf(o[d0][r] * rli[r]); }
  asm volatile("s_waitcnt lgkmcnt(0)" ::: "memory");
  bf16* Ow = (bf16*)((unsigned char*)Ob + (long)(wid * QBLK) * 2048); const bf16* Gw = Gb + (long)(wid * QBLK) * ld;
#pragma unroll 2
  for (int c = 0; c < 8; ++c) { const int idx = c * 64 + lane, row = idx >> 4, ch = (idx & 15) * 8;
    const u32x4 ov = *(const u32x4*)(ot + row * 136 + ch); const u32x4 gv = *(const u32x4*)(Gw + (long)row * ld + ch); float f[8];
#pragma unroll
    for (int e = 0; e < 4; ++e) { const float g0 = ::bf_lo(gv[e]), g1 = ::bf_hi(gv[e]); f[2 * e] = ::bf_lo(ov[e]) * ::siluf_(g0) * OG_SCALE; f[2 * e + 1] = ::bf_hi(ov[e]) * ::siluf_(g1) * OG_SCALE; }
    u32x2 w; w.x = ::pack4_fp8_sat((f32x4){f[0], f[1], f[2], f[3]}); w.y = ::pack4_fp8_sat((f32x4){f[4], f[5], f[6], f[7]});
    *(u32x2*)((unsigned char*)Ow + (long)row * 2048 + ch) = w; }
  __syncthreads();
#undef SLOAD
#undef SWRITE
#undef SWAIT
#undef RESC
}

__device__ __forceinline__ void na_wave(const bf16* __restrict__ PB, bf16* __restrict__ OG, const float* rpb, int qrow, int c0, int h, char* wlds, int lane) {
  constexpr int ld = LDE;
  const int r32 = lane & 31, hi = lane >> 5;
  const bf16* Qw = PB + (size_t)(qrow * 64 + c0 + r32) * ld + h * 128 + hi * 8;
  bf16x8 qr[8];
#pragma unroll
  for (int d0 = 0; d0 < 8; ++d0) qr[d0] = *(const bf16x8*)(Qw + d0 * 16);
  float m_reg = -1e30f, l_reg = 0.f; f32x16 o[4] = {};
  float* al_l = (float*)(wlds + 16384);
  int rs = qrow - 4; rs = rs < 0 ? 0 : (rs > 120 ? 120 : rs);
  const int qc = c0 + r32; int cs = qc - 8; cs = cs < 0 ? 0 : (cs > 48 ? 48 : cs);
  const int vb0 = (int)(uintptr_t)wlds + v_rd_base(lane);
  const int skey = lane >> 4, scol = (lane & 15) * 8;
  for (int j = 0; j < 12; ++j) {
    const int krow = j < 4 ? SEQ + 64 * j : (rs + j - 4) * 64;
    const bf16* Kt = PB + (size_t)krow * ld + 1024 + h * 128; const bf16* Vt = Kt + 1024;
#pragma unroll
    for (int hf = 0; hf < 2; ++hf) { bf16x8 v[8];
#pragma unroll
      for (int it = 0; it < 8; ++it) v[it] = *(const bf16x8*)(Vt + (size_t)((hf * 8 + it) * 4 + skey) * ld + scol);
#pragma unroll
      for (int it = 0; it < 8; ++it) *(bf16x8*)(wlds + v_st((hf * 8 + it) * 4 + skey, scol)) = v[it]; }
    f32x16 p0 = {}, p1 = {};
#pragma unroll
    for (int d0 = 0; d0 < 8; ++d0) { const bf16x8 b0 = *(const bf16x8*)(Kt + (size_t)r32 * ld + d0 * 16 + hi * 8), b1 = *(const bf16x8*)(Kt + (size_t)(32 + r32) * ld + d0 * 16 + hi * 8);
      p0 = __builtin_amdgcn_mfma_f32_32x32x16_bf16(b0, qr[d0], p0, 0, 0, 0); p1 = __builtin_amdgcn_mfma_f32_32x32x16_bf16(b1, qr[d0], p1, 0, 0, 0); }
    if (j >= 4) { const int bi = (rs + j - 4 - qrow + 7) * 31 - qc + 15;
#pragma unroll
      for (int r = 0; r < 16; ++r) { const int kc = crow(r, hi);
        { const bool ok = (kc >= cs) && (kc < cs + 16); const float b = rpb[ok ? bi + kc : 0]; p0[r] = ok ? p0[r] + b : -1e30f; }
        { const int k1 = kc + 32; const bool ok = (k1 >= cs) && (k1 < cs + 16); const float b = rpb[ok ? bi + k1 : 0]; p1[r] = ok ? p1[r] + b : -1e30f; } } }
#ifdef EXP_NA_UNIFORM
#pragma unroll
    for (int r = 0; r < 16; ++r) { if (p0[r] > -1e29f) p0[r] = 0.f; if (p1[r] > -1e29f) p1[r] = 0.f; }
#endif
    float mn, alpha; bf16x8 pa0, pa1, pa2, pa3;
    partialSM(p0, p1, m_reg, mn, alpha);
    finishSM(p0, p1, alpha, l_reg, pa0, pa1, pa2, pa3);
    if (__any(alpha < 1.f)) { if (hi == 0) al_l[r32] = alpha; asm volatile("s_waitcnt lgkmcnt(0)" ::: "memory");
#pragma unroll
      for (int d = 0; d < 4; ++d)
#pragma unroll
        for (int r = 0; r < 16; ++r) o[d][r] *= al_l[crow(r, hi)]; }
    pv_d0(o, vb0, pa0, pa1, pa2, pa3);
  }
  if (hi == 0) al_l[r32] = l_reg; asm volatile("s_waitcnt lgkmcnt(0)" ::: "memory");
  float rli[16];
#pragma unroll
  for (int r = 0; r < 16; ++r) rli[r] = __builtin_amdgcn_rcpf(al_l[crow(r, hi)]);
  bf16* ot = (bf16*)wlds;
#pragma unroll
  for (int r = 0; r < 16; ++r) { const int orow = crow(r, hi);
#pragma unroll
    for (int d0 = 0; d0 < 4; ++d0) ot[orow * 136 + d0 * 32 + r32] = ::f2bf(o[d0][r] * rli[r]); }
  asm volatile("s_waitcnt lgkmcnt(0)" ::: "memory");
  const size_t t0 = (size_t)(qrow * 64 + c0);
#pragma unroll 2
  for (int c = 0; c < 8; ++c) { const int idx = c * 64 + lane, row = idx >> 4, ch = (idx & 15) * 8;
    const u32x4 ov = *(const u32x4*)(ot + row * 136 + ch); const u32x4 gv = *(const u32x4*)(PB + (t0 + row) * ld + 3072 + h * 128 + ch); float f[8];
#pragma unroll
    for (int e = 0; e < 4; ++e) { const float g0 = ::bf_lo(gv[e]), g1 = ::bf_hi(gv[e]); f[2 * e] = ::bf_lo(ov[e]) * ::siluf_(g0) * OG_SCALE; f[2 * e + 1] = ::bf_hi(ov[e]) * ::siluf_(g1) * OG_SCALE; }
    u32x2 w; w.x = ::pack4_fp8_sat((f32x4){f[0], f[1], f[2], f[3]}); w.y = ::pack4_fp8_sat((f32x4){f[4], f[5], f[6], f[7]});
    *(u32x2*)((unsigned char*)OG + (t0 + row) * 2048 + h * 128 + ch) = w; }
  asm volatile("s_waitcnt lgkmcnt(0)" ::: "memory");
}
}

constexpr size_t MiB = 1u << 20;
constexpr size_t WS_WEVIN = 1 * MiB, WS_WEVOUT = 49 * MiB, WS_WGLU = 65 * MiB, WS_WODIN = 69 * MiB, WS_WODOUT = 109 * MiB;
constexpr size_t WS_T1 = 125 * MiB, WS_T2 = 141 * MiB, WS_LAM = 173 * MiB;
constexpr size_t WS_MODP = 430 * MiB, WS_MOD = 178 * MiB;
constexpr size_t WS_X = 179 * MiB, WS_H = 245 * MiB, WS_P = 278 * MiB, WS_OG = 380 * MiB, WS_ZB = 413 * MiB, WS_S = 430 * MiB, WS_HB = 463 * MiB, WS_END = 480 * MiB;
constexpr int LDS_BYTES = 131072 + 8192;
constexpr int NPH = 27;

struct Params {
    const float *x, *c, *ctx, *c_ctx, *ada_w, *ada_b, *ln_g, *ln_b, *ev_w_in, *ev_w_out, *na_rpb, *s5_a_re, *s5_a_im, *s5_log_dt, *s5_b_re, *s5_b_im, *s5_c_re, *s5_c_im, *s5_d,
        *s5_glu_w, *s5_glu_b, *od_w_in, *od_w_out, *q_norm_g, *k_norm_g;
    float* out; unsigned char* ws; int ph_lo, ph_hi;
};

struct TrItem { const float* W; bf16_t* WT; int K, N, item; float sc; bool fp8; };
__device__ __forceinline__ void tr_load(const TrItem& m, int lane, f32x4 (&v)[16]) {
    const int nblk = m.N / 64, kb = m.item / nblk, nb = m.item % nblk, k0 = 64 * kb, n0 = 64 * nb;
#pragma unroll
    for (int i = 0; i < 16; ++i) v[i] = *(const f32x4*)(m.W + (size_t)(k0 + 4 * i + (lane >> 4)) * m.N + n0 + (lane & 15) * 4);
}
__device__ __forceinline__ void tr_store(const TrItem& m, int lane, const f32x4 (&v)[16], LAS float* scr) {
    const int nblk = m.N / 64, kb = m.item / nblk, nb = m.item % nblk, k0 = 64 * kb, n0 = 64 * nb, K = m.K;
#pragma unroll
    for (int i = 0; i < 16; ++i) { LAS float* d = scr + (4 * i + (lane >> 4)) * 65 + (lane & 15) * 4; d[0] = v[i][0]; d[1] = v[i][1]; d[2] = v[i][2]; d[3] = v[i][3]; }
    asm volatile("s_waitcnt lgkmcnt(0)" ::: "memory");
    const int c = lane & 7;
#pragma unroll
    for (int j = 0; j < 8; ++j) { const int n = (lane >> 3) + 8 * j; const LAS float* s = scr + (8 * c) * 65 + n;
        if (m.fp8) { u32x2 o; o.x = pack4_fp8((f32x4){s[0 * 65], s[1 * 65], s[2 * 65], s[3 * 65]} * m.sc); o.y = pack4_fp8((f32x4){s[4 * 65], s[5 * 65], s[6 * 65], s[7 * 65]} * m.sc);
            *(u32x2*)((unsigned char*)m.WT + (size_t)(n0 + n) * K + k0 + 8 * c) = o; }
        else { u32x4 o; o.x = cvt_pk_bf16(s[0 * 65], s[1 * 65]); o.y = cvt_pk_bf16(s[2 * 65], s[3 * 65]); o.z = cvt_pk_bf16(s[4 * 65], s[5 * 65]); o.w = cvt_pk_bf16(s[6 * 65], s[7 * 65]);
            *(u32x4*)(m.WT + (size_t)(n0 + n) * K + k0 + 8 * c) = o; } }
    asm volatile("s_waitcnt lgkmcnt(0)" ::: "memory");
}

__device__ __forceinline__ void s5_tables_item(const Params& P, int i, int g, LAS float* L) {
    LAS float* pw = L;
    LAS float* BbRe = L + 4352;
    LAS float* BbIm = BbRe + 2048;
    LAS float* CRe = BbIm + 2048;
    LAS float* CIm = CRe + 2048;
    LAS float* Kt = CIm + 2048;
    const int tid = ltid();
    bf16_t* T1 = (bf16_t*)(lws(P.ws) + WS_T1) + (size_t)(i * 64 + g) * 256 * 256;
    bf16_t* T2 = (bf16_t*)(lws(P.ws) + WS_T2) + (size_t)(i * 64 + g) * 256 * 512;
    float* LAM = (float*)(lws(P.ws) + WS_LAM) + (size_t)(i * 64 + g) * 256;
    __syncthreads();
    if (tid < 128) {
        const int dir = tid >> 6, pp = tid & 63, idx = (i * 2 + dir) * 64 + g;
        const float dt = __expf(P.s5_log_dt[idx]), are = P.s5_a_re[idx * 64 + pp], aim = P.s5_a_im[idx * 64 + pp];
        const float mag = __expf(are * dt); float rev = aim * dt * 0.15915494309189535f; rev -= floorf(rev);
        const float lre = mag * __builtin_amdgcn_cosf(rev), lim = mag * __builtin_amdgcn_sinf(rev);
        const float den = are * are + aim * aim, nre = lre - 1.f, nim = lim;
        const float fre = (nre * are + nim * aim) / den, fim = (nim * are - nre * aim) / den;
        float cr = 1.f, ci = 0.f;
        for (int d = 0; d <= 16; ++d) { pw[((dir * 17 + d) * 64 + pp) * 2] = cr; pw[((dir * 17 + d) * 64 + pp) * 2 + 1] = ci; const float nr = cr * lre - ci * lim, ni = cr * lim + ci * lre; cr = nr; ci = ni; }
        LAM[(dir * 64 + pp) * 2] = pw[((dir * 17 + 16) * 64 + pp) * 2]; LAM[(dir * 64 + pp) * 2 + 1] = pw[((dir * 17 + 16) * 64 + pp) * 2 + 1];
        for (int c = 0; c < 16; ++c) { const float bre = P.s5_b_re[(size_t)(idx * 64 + pp) * 16 + c], bim = P.s5_b_im[(size_t)(idx * 64 + pp) * 16 + c];
            BbRe[(dir * 64 + pp) * 16 + c] = fre * bre - fim * bim; BbIm[(dir * 64 + pp) * 16 + c] = fre * bim + fim * bre; }
    }
    for (int e = tid; e < 2048; e += 512) { const int dir = e >> 10, r = e & 1023; const size_t src = (size_t)((i * 2 + dir) * 64 + g) * 1024 + r; CRe[e] = P.s5_c_re[src]; CIm[e] = P.s5_c_im[src]; }
    __syncthreads();
    {   const int dir = tid >> 8, d = (tid >> 4) & 15, co = tid & 15; float acc[16];
#pragma unroll
        for (int c = 0; c < 16; ++c) acc[c] = 0.f;
        for (int pp = 0; pp < 64; ++pp) { const float cr = CRe[(dir * 16 + co) * 64 + pp], ci = CIm[(dir * 16 + co) * 64 + pp], wr_ = pw[((dir * 17 + d) * 64 + pp) * 2], wi = pw[((dir * 17 + d) * 64 + pp) * 2 + 1];
            const float gre = cr * wr_ - ci * wi, gim = cr * wi + ci * wr_;
#pragma unroll
            for (int c = 0; c < 16; ++c) acc[c] += gre * BbRe[(dir * 64 + pp) * 16 + c] - gim * BbIm[(dir * 64 + pp) * 16 + c]; }
#pragma unroll
        for (int c = 0; c < 16; ++c) Kt[((dir * 16 + d) * 16 + co) * 16 + c] = acc[c];
    }
    __syncthreads();
    for (int ch = tid; ch < 16384; ch += 512) {
        const int f = ch >> 6, cc = ch & 63, t = f >> 4, co = f & 15; float v[8];
        if (cc < 32) { const int s = cc >> 1, ci0 = (cc & 1) * 8;
#pragma unroll
            for (int e = 0; e < 8; ++e) { const int ci = ci0 + e; float a = 0.f;
#ifndef EXP_NO_SCAN
                if (t >= s) a += Kt[((0 * 16 + (t - s)) * 16 + co) * 16 + ci];
                if (s >= t) a += Kt[((1 * 16 + (s - t)) * 16 + co) * 16 + ci];
#endif
                if (s == t && co == ci) a += P.s5_d[i * 1024 + g * 16 + co];
                v[e] = a; }
        } else { const int q = (cc - 32) >> 3, p0 = ((cc - 32) & 7) * 8, dir = q >> 1, im = q & 1, pwr = dir == 0 ? t + 1 : 16 - t;
#pragma unroll
            for (int e = 0; e < 8; ++e) { const int pp = p0 + e; const float cr = CRe[(dir * 16 + co) * 64 + pp], ci = CIm[(dir * 16 + co) * 64 + pp], wr_ = pw[((dir * 17 + pwr) * 64 + pp) * 2], wi = pw[((dir * 17 + pwr) * 64 + pp) * 2 + 1];
                v[e] = im ? -(cr * wi + ci * wr_) : (cr * wr_ - ci * wi);
#if defined(EXP_NO_SCAN) || defined(EXP_NO_CARRY)
                v[e] = 0.f;
#endif
#ifdef EXP_NO_CARRY_B
                if (dir == 1) v[e] = 0.f;
#endif
            } }
        u32x4 w; w.x = cvt_pk_bf16(v[0], v[1]); w.y = cvt_pk_bf16(v[2], v[3]); w.z = cvt_pk_bf16(v[4], v[5]); w.w = cvt_pk_bf16(v[6], v[7]);
        *(u32x4*)(T2 + ((size_t)(((f >> 5) * 32 + (cc >> 1)) * 64 + (cc & 1) * 32 + (f & 31))) * 8) = w;
    }
    for (int ch = tid; ch < 8192; ch += 512) {
        const int row = ch >> 5, cc = ch & 31, s = cc >> 1, ci0 = (cc & 1) * 8, dir = row >> 7, im = (row >> 6) & 1, pp = row & 63, pwr = dir == 0 ? 15 - s : s; float v[8];
        const float wr_ = pw[((dir * 17 + pwr) * 64 + pp) * 2], wi = pw[((dir * 17 + pwr) * 64 + pp) * 2 + 1];
#pragma unroll
        for (int e = 0; e < 8; ++e) { const float br = BbRe[(dir * 64 + pp) * 16 + ci0 + e], bi = BbIm[(dir * 64 + pp) * 16 + ci0 + e]; v[e] = im ? (wr_ * bi + wi * br) : (wr_ * br - wi * bi); }
        u32x4 w; w.x = cvt_pk_bf16(v[0], v[1]); w.y = cvt_pk_bf16(v[2], v[3]); w.z = cvt_pk_bf16(v[4], v[5]); w.w = cvt_pk_bf16(v[6], v[7]);
        *(u32x4*)(T1 + ((size_t)(((row >> 5) * 16 + (cc >> 1)) * 64 + (cc & 1) * 32 + (row & 31))) * 8) = w;
    }
    __syncthreads();
}

__device__ __forceinline__ TrItem seg_item(const Params& P, unsigned char* ws, int seg, int j) {
    TrItem m; m.K = 2048; m.N = 2048; m.fp8 = true; m.sc = WOUT_SCALE;
    const int i = seg >= 2 ? 1 : 0;
    if (seg == 0 || (seg == 2 && j < 3072)) { m.W = P.ev_w_in + (size_t)i * 2048 * 6144; m.N = 6144; m.sc = WIN_SCALE; m.WT = (bf16_t*)(ws + WS_WEVIN + (size_t)i * 6144 * 2048); }
    else if (seg == 1 || seg == 2) {
        if (seg == 2) j -= 3072;
        if (j < 1024) { m.W = P.ev_w_out + (size_t)i * 2048 * 2048; m.WT = (bf16_t*)(ws + WS_WEVOUT + (size_t)i * 2048 * 2048); }
        else if ((j -= 1024) < 256) { m.W = P.s5_glu_w + (size_t)i * 1024 * 1024; m.K = 1024; m.N = 1024; m.fp8 = false; m.sc = 1.f; m.WT = (bf16_t*)(ws + WS_WGLU) + (size_t)i * 1024 * 1024; }
        else if ((j -= 256) < 2560) { m.W = P.od_w_in + (size_t)i * 2048 * 5120; m.N = 5120; m.sc = WIN_SCALE; m.WT = (bf16_t*)(ws + WS_WODIN + (size_t)i * 5120 * 2048); }
        else { j -= 2560; m.W = P.od_w_out + (size_t)i * 2048 * 2048; m.WT = (bf16_t*)(ws + WS_WODOUT + (size_t)i * 2048 * 2048); }
    } else if (seg == 3) { m.W = P.od_w_in + (size_t)i * 2048 * 5120; m.N = 5120; m.sc = WIN_SCALE; m.WT = (bf16_t*)(ws + WS_WODIN + (size_t)i * 5120 * 2048); }
    else { m.W = P.od_w_out + (size_t)i * 2048 * 2048; m.WT = (bf16_t*)(ws + WS_WODOUT + (size_t)i * 2048 * 2048); }
    m.item = j; return m;
}
__device__ __forceinline__ void convert_seg(const Params& P, int seg, int vw, int nvw, LAS float* scr, int lane) {
    unsigned char* ws = lws(P.ws);
    const int nitems = seg == 0 ? 3072 : seg == 1 ? 4864 : seg == 2 ? 4352 : seg == 3 ? 2560 : 1024;
    f32x4 va[16], vb[16]; TrItem m0, m1; int j = vw;
    if (j < nitems) { m0 = seg_item(P, ws, seg, j); tr_load(m0, lane, va); }
    while (j < nitems) {
        const int j1 = j + nvw, j2 = j1 + nvw;
        if (j1 < nitems) { m1 = seg_item(P, ws, seg, j1); tr_load(m1, lane, vb); }
        tr_store(m0, lane, va, scr);
        if (j2 < nitems) { m0 = seg_item(P, ws, seg, j2); tr_load(m0, lane, va); }
        if (j1 < nitems) tr_store(m1, lane, vb, scr);
        j = j2;
    }
}
__device__ __forceinline__ void phase_prologue(const Params& P, LAS unsigned char* lds) {
    const int tid = ltid(), lane = tid & 63, wid = tid >> 6, G = gridDim.x;
    unsigned char* ws = lws(P.ws);
    if (lbid() < 128) s5_tables_item(P, lbid() >> 6, lbid() & 63, (LAS float*)lds);
    __syncthreads();
    {
        LAS float* sv = (LAS float*)lds;
        for (int e = tid; e < 2048; e += 512) { sv[e] = siluf_(P.c[e]); sv[2048 + e] = siluf_(P.c_ctx[e]); }
        __syncthreads();
        float* MODP = (float*)(ws + WS_MODP);
        for (int it = lbid(); it < 768; it += G) {
            const int l = it / 192, rem = it % 192, cb = rem >> 6, ks = rem & 63, col = cb * 2048 + tid * 4;
            const float* w = P.ada_w + ((size_t)l * 2048 + ks * 32) * 6144 + col; f32x4 a0 = {0.f, 0.f, 0.f, 0.f}, a1 = {0.f, 0.f, 0.f, 0.f};
#pragma unroll 16
            for (int k = 0; k < 32; ++k) { const f32x4 wv = *(const f32x4*)(w + (size_t)k * 6144); a0 += wv * sv[ks * 32 + k]; a1 += wv * sv[2048 + ks * 32 + k]; }
            *(f32x4*)(MODP + ((size_t)(l * 64 + ks) * 2 + 0) * 6144 + col) = a0; *(f32x4*)(MODP + ((size_t)(l * 64 + ks) * 2 + 1) * 6144 + col) = a1;
        }
    }
    __syncthreads();
    if (lbid() >= 128) convert_seg(P, 0, (lbid() - 128) * 8 + wid, (G - 128) * 8, (LAS float*)(lds + wid * 16640), lane);
}

__device__ __forceinline__ void phase_finalize_mod(const Params& P) {
    const float* MODP = (const float*)(lws(P.ws) + WS_MODP); float* MOD = (float*)(lws(P.ws) + WS_MOD);
    for (int e = lbid() * 512 + ltid(); e < 4 * 2 * 6144; e += gridDim.x * 512) {
        const int l = e / 12288, v = (e / 6144) & 1, col = e % 6144; float s = P.ada_b[l * 6144 + col];
        for (int ks = 0; ks < 64; ++ks) s += MODP[((size_t)(l * 64 + ks) * 2 + v) * 6144 + col];
        MOD[e] = s;
    }
}
__device__ __forceinline__ void mod_row(const f32x4 (&v)[8], const float* sh, const float* sc, bf16_t* hrow, int lane) {
#pragma unroll
    for (int j = 0; j < 8; ++j) { const int col = 4 * lane + 256 * j; const f32x4 s = *(const f32x4*)(sc + col), t = *(const f32x4*)(sh + col); const f32x4 h = v[j] * (s + 1.f) + t;
        *(unsigned*)((unsigned char*)hrow + col) = pack4_fp8(h); }
}
__device__ __forceinline__ void phase_mod0(const Params& P) {
    const int lane = ltid() & 63, gw = lbid() * 8 + (ltid() >> 6), NGW = gridDim.x * 8;
    const float* MOD = (const float*)(lws(P.ws) + WS_MOD); unsigned char* H = lws(P.ws) + WS_H;
    {
        f32x4 s1[8], t[8];
#pragma unroll
        for (int j = 0; j < 8; ++j) { const int col = 4 * lane + 256 * j; s1[j] = *(const f32x4*)(MOD + 1 * 2048 + col) + 1.f; t[j] = *(const f32x4*)(MOD + col); }
        for (int r = gw; r < SEQ; r += 4 * NGW) { f32x4 x[4][8];
#pragma unroll
            for (int k = 0; k < 4; ++k) { const int rk = r + k * NGW; if (rk < SEQ) {
#pragma unroll
                for (int j = 0; j < 8; ++j) x[k][j] = *(const f32x4*)(P.x + (size_t)rk * DM + 4 * lane + 256 * j); } }
#pragma unroll
            for (int k = 0; k < 4; ++k) { const int rk = r + k * NGW; if (rk < SEQ) { unsigned char* hrow = H + (size_t)rk * DM;
#pragma unroll
                for (int j = 0; j < 8; ++j) { const f32x4 h = x[k][j] * s1[j] + t[j]; *(unsigned*)(hrow + 4 * lane + 256 * j) = pack4_fp8(h); } } }
        }
    }
    for (int r = SEQ + gw; r < MROWS; r += NGW) { f32x4 x[8];
#pragma unroll
        for (int j = 0; j < 8; ++j) x[j] = *(const f32x4*)(P.ctx + (size_t)(r - SEQ) * DM + 4 * lane + 256 * j);
        mod_row(x, MOD + (size_t)((0 * 2 + 1) * 3 + 0) * 2048, MOD + (size_t)((0 * 2 + 1) * 3 + 1) * 2048, (bf16_t*)(H + (size_t)r * DM), lane); }
}
__device__ __forceinline__ void ln_one(f32x4 (&v)[8]) {
    float s = 0.f;
#pragma unroll
    for (int j = 0; j < 8; ++j) s += (v[j][0] + v[j][1]) + (v[j][2] + v[j][3]);
    const float mean = wave_sum(s) * (1.f / DM); float q = 0.f;
#pragma unroll
    for (int j = 0; j < 8; ++j) { v[j] = v[j] - mean; q += (v[j][0] * v[j][0] + v[j][1] * v[j][1]) + (v[j][2] * v[j][2] + v[j][3] * v[j][3]); }
    const float rstd = 1.f / sqrtf(wave_sum(q) * (1.f / DM) + LN_EPS);
#pragma unroll
    for (int j = 0; j < 8; ++j) v[j] = v[j] * rstd;
}
__device__ __forceinline__ void phase_ln(const Params& P, int l) {
    const int lane = ltid() & 63, gw = lbid() * 8 + (ltid() >> 6), NGW = gridDim.x * 8;
    const float* MOD = (const float*)(lws(P.ws) + WS_MOD); unsigned char* H = lws(P.ws) + WS_H;   float* X = (float*)(lws(P.ws) + WS_X);
    const float* gam = P.ln_g + l * DM; const float* bet = P.ln_b + l * DM; const bool last = (l == 3);
    {
        const float* sh = MOD + (size_t)(((last ? l : l + 1) * 2 + 0) * 3 + 0) * 2048; const float* sc = sh + 2048;
        f32x4 ga[8], be[8], cur[8], nxt[8];
#pragma unroll
        for (int j = 0; j < 8; ++j) { const int col = 4 * lane + 256 * j; ga[j] = *(const f32x4*)(gam + col); be[j] = *(const f32x4*)(bet + col); }
        int r = gw;
        if (r < SEQ) {
#pragma unroll
            for (int j = 0; j < 8; ++j) cur[j] = *(const f32x4*)(X + (size_t)r * DM + 4 * lane + 256 * j); }
        for (; r < SEQ; r += NGW) { const int rn = r + NGW;
            if (rn < SEQ) {
#pragma unroll
                for (int j = 0; j < 8; ++j) nxt[j] = *(const f32x4*)(X + (size_t)rn * DM + 4 * lane + 256 * j); }
            ln_one(cur);
            float* dst = last ? P.out + (size_t)r * DM : X + (size_t)r * DM; bf16_t* hrow = (bf16_t*)(H + (size_t)r * DM);
#pragma unroll
            for (int j = 0; j < 8; ++j) { const int col = 4 * lane + 256 * j; const f32x4 y = cur[j] * ga[j] + be[j]; *(f32x4*)(dst + col) = y;
                if (!last) { const f32x4 h = y * (*(const f32x4*)(sc + col) + 1.f) + *(const f32x4*)(sh + col); *(unsigned*)((unsigned char*)hrow + col) = pack4_fp8(h); } }
#pragma unroll
            for (int j = 0; j < 8; ++j) cur[j] = nxt[j]; }
    }
    if (!last) for (int r = SEQ + gw; r < MROWS; r += NGW) {
        float* xr = X + (size_t)r * DM; f32x4 v[8]; const float* xsrc = l == 0 ? P.ctx + (size_t)(r - SEQ) * DM : xr;
        const float* part = (const float*)(lws(P.ws) + WS_S) + (size_t)(r - SEQ) * DM; const float* gtc = MOD + (size_t)((l * 2 + 1) * 3 + 2) * 2048;
#pragma unroll
        for (int j = 0; j < 8; ++j) { const int col = 4 * lane + 256 * j; f32x4 a = *(const f32x4*)(part + col);
#pragma unroll
            for (int ks = 1; ks < 4; ++ks) a += *(const f32x4*)(part + (size_t)ks * 256 * 2048 + col);
            v[j] = *(const f32x4*)(xsrc + col) * DN_ALPHA + *(const f32x4*)(gtc + col) * a; }
        ln_one(v);
#pragma unroll
        for (int j = 0; j < 8; ++j) { const int col = 4 * lane + 256 * j; v[j] = v[j] * *(const f32x4*)(gam + col) + *(const f32x4*)(bet + col); *(f32x4*)(xr + col) = v[j]; }
        mod_row(v, MOD + (size_t)(((l + 1) * 2 + 1) * 3 + 0) * 2048, MOD + (size_t)(((l + 1) * 2 + 1) * 3 + 1) * 2048, (bf16_t*)(H + (size_t)r * DM), lane); }
}
__device__ __forceinline__ bool odd_fix_ok(const Params& P, int i, int lane) {
    float mq = fmaxf(fabsf(P.q_norm_g[i * 128 + lane]), fabsf(P.q_norm_g[i * 128 + 64 + lane])), mk = fmaxf(fabsf(P.k_norm_g[i * 128 + lane]), fabsf(P.k_norm_g[i * 128 + 64 + lane]));
#pragma unroll
    for (int o = 1; o < 64; o <<= 1) { mq = fmaxf(mq, __shfl_xor(mq, o)); mk = fmaxf(mk, __shfl_xor(mk, o)); }
    return 11.313708498984761f * mq * mk * 1.02f * 1.4426950408889634f <= 64.f;
}
__device__ __forceinline__ void phase_qknorm(const Params& P, int i) {
    const int lane = ltid() & 63, gw = lbid() * 8 + (ltid() >> 6), NGW = gridDim.x * 8, c = lane & 7, hsub = lane >> 3;
    bf16_t* PB = (bf16_t*)(lws(P.ws) + WS_P);
    float gq1[8], gq2[8], gk1[8], gk2[8], inv[8]; const bool fixok = odd_fix_ok(P, i, lane);
#pragma unroll
    for (int e = 0; e < 8; ++e) { const int d = 8 * c + e; gq1[e] = P.q_norm_g[i * 128 + d]; gq2[e] = P.q_norm_g[i * 128 + 64 + d]; gk1[e] = P.k_norm_g[i * 128 + d]; gk2[e] = P.k_norm_g[i * 128 + 64 + d];
        inv[e] = exp2f(-(float)(d & 31) * (13.287712379549449f / 32.f)) * 0.15915494309189535f; }
    u32x4 av[3], bv[3], an[3], bn[3];
    if (gw < MROWS) {
#pragma unroll
        for (int ps = 0; ps < 3; ++ps) { const int hd = ps * 8 + hsub; if (hd < 20) { av[ps] = *(const u32x4*)(PB + (size_t)gw * LDO + hd * 128 + 8 * c); bv[ps] = *(const u32x4*)(PB + (size_t)gw * LDO + hd * 128 + 64 + 8 * c); } } }
    for (int r = gw; r < MROWS; r += NGW) {
        bf16_t* row = PB + (size_t)r * LDO;
        if (r + NGW < MROWS) { const bf16_t* rn = PB + (size_t)(r + NGW) * LDO;
#pragma unroll
            for (int ps = 0; ps < 3; ++ps) { const int hd = ps * 8 + hsub; if (hd < 20) { an[ps] = *(const u32x4*)(rn + hd * 128 + 8 * c); bn[ps] = *(const u32x4*)(rn + hd * 128 + 64 + 8 * c); } } }
        float cs[8], sn[8];
        if (r < SEQ) { const float pos = (float)(c < 4 ? (r >> 6) : (r & 63));
#pragma unroll
            for (int e = 0; e < 8; ++e) { float rev = pos * inv[e]; rev -= floorf(rev); cs[e] = __builtin_amdgcn_cosf(rev); sn[e] = __builtin_amdgcn_sinf(rev); } }
        else {
#pragma unroll
            for (int e = 0; e < 8; ++e) { cs[e] = 1.f; sn[e] = 0.f; } }
#pragma unroll
        for (int ps = 0; ps < 3; ++ps) { const int hd = ps * 8 + hsub; const bool act = hd < 20;
            float a[8], b[8]; float ss = 0.f;
#pragma unroll
            for (int e = 0; e < 4; ++e) { a[2 * e] = act ? bf_lo(av[ps][e]) : 0.f; a[2 * e + 1] = act ? bf_hi(av[ps][e]) : 0.f; b[2 * e] = act ? bf_lo(bv[ps][e]) : 0.f; b[2 * e + 1] = act ? bf_hi(bv[ps][e]) : 0.f; }
#pragma unroll
            for (int e = 0; e < 8; ++e) ss += a[e] * a[e] + b[e] * b[e];
            ss += __shfl_xor(ss, 1); ss += __shfl_xor(ss, 2); ss += __shfl_xor(ss, 4);
            const float rstd = 1.f / sqrtf(ss * (1.f / 128.f) + RMS_EPS); const bool isq = hd < 16;
            u32x4 oa, ob;
            const float rq = (isq && fixok) ? rstd * (att::SCALE * 1.4426950408889634f) : rstd;
#pragma unroll
            for (int e = 0; e < 4; ++e) { float x0 = a[2 * e] * rq * (isq ? gq1[2 * e] : gk1[2 * e]), x1 = a[2 * e + 1] * rq * (isq ? gq1[2 * e + 1] : gk1[2 * e + 1]);
                float y0 = b[2 * e] * rq * (isq ? gq2[2 * e] : gk2[2 * e]), y1 = b[2 * e + 1] * rq * (isq ? gq2[2 * e + 1] : gk2[2 * e + 1]);
                oa[e] = cvt_pk_bf16(x0 * cs[2 * e] - y0 * sn[2 * e], x1 * cs[2 * e + 1] - y1 * sn[2 * e + 1]);
                ob[e] = cvt_pk_bf16(y0 * cs[2 * e] + x0 * sn[2 * e], y1 * cs[2 * e + 1] + x1 * sn[2 * e + 1]); }
            if (act) { *(u32x4*)(row + hd * 128 + 8 * c) = oa; *(u32x4*)(row + hd * 128 + 64 + 8 * c) = ob; } }
#pragma unroll
        for (int ps = 0; ps < 3; ++ps) { av[ps] = an[ps]; bv[ps] = bn[ps]; }
    }
}

__device__ __forceinline__ void s5_stage_z(const bf16_t* __restrict__ PB, const bf16_t* __restrict__ HBg, unsigned char* ldsB, int g, int cb, int nks, int tid) {
    for (int piece = tid; piece < nks * 64; piece += 512) { const int ks = piece >> 6, ln = piece & 63, r32 = ln & 31, hi = ln >> 5; int bc = cb * 32 + r32; bc = bc < NCHUNK ? bc : NCHUNK - 1;
        const bf16_t* src = ks < 16 ? PB + (size_t)(bc * 16 + ks) * LDE + 4096 + g * 16 + hi * 8 : HBg + (size_t)bc * 256 + (ks - 16) * 16 + hi * 8;
        *(bf16x8*)(ldsB + piece * 16) = *(const bf16x8*)src; }
}
__device__ __forceinline__ void s5_gemm1_item(const bf16_t* __restrict__ PB, const bf16_t* __restrict__ T1g, float* __restrict__ Sg, unsigned char* ldsB, int g, int cb, int tid) {
    const int wid = tid >> 6, lane = tid & 63, r32 = lane & 31, hi = lane >> 5, bc = cb * 32 + r32;
    s5_stage_z(PB, nullptr, ldsB, g, cb, 16, tid);
    __syncthreads();
    f32x16 acc = {};
#pragma unroll
    for (int ks = 0; ks < 16; ++ks) { const bf16x8 a = *(const bf16x8*)(T1g + ((size_t)(wid * 16 + ks) * 64 + lane) * 8), b = *(const bf16x8*)(ldsB + (ks * 64 + lane) * 16); acc = __builtin_amdgcn_mfma_f32_32x32x16_bf16(a, b, acc, 0, 0, 0); }
    if (bc < NCHUNK) {
#pragma unroll
        for (int q = 0; q < 4; ++q) { const f32x4 v = {acc[4 * q], acc[4 * q + 1], acc[4 * q + 2], acc[4 * q + 3]}; *(f32x4*)(Sg + (size_t)bc * 256 + wid * 32 + 8 * q + 4 * hi) = v; } }
    __syncthreads();
}
__device__ __forceinline__ void s5_scan_item(const float* __restrict__ Sg, bf16_t* __restrict__ HBg, const float* __restrict__ LAMg, int dir, float* xl, int tid) {
    const int wid = tid >> 6, lane = tid & 63;
    const float lre = LAMg[(dir * 64 + lane) * 2], lim = LAMg[(dir * 64 + lane) * 2 + 1]; const int off = dir * 128 + lane;
#define S5_BC(n) (dir == 0 ? ((n) < 16 ? 512 + (n) : (n) - 16) : 527 - (n))
    const int n0 = wid * 66;
    float er = 0.f, ei = 0.f, pr = 1.f, pi = 0.f;
    for (int b = 0; b < 6; ++b) { float sr[11], si[11];
#pragma unroll
        for (int k = 0; k < 11; ++k) { const int bc = S5_BC(n0 + b * 11 + k); sr[k] = Sg[(size_t)bc * 256 + off]; si[k] = Sg[(size_t)bc * 256 + off + 64]; }
#pragma unroll
        for (int k = 0; k < 11; ++k) { const float tr = lre * er - lim * ei + sr[k], ti = lre * ei + lim * er + si[k]; er = tr; ei = ti; const float qr = pr * lre - pi * lim, qi = pr * lim + pi * lre; pr = qr; pi = qi; } }
    __syncthreads();
    xl[(wid * 64 + lane) * 2] = er; xl[(wid * 64 + lane) * 2 + 1] = ei;
    __syncthreads();
    float hr = 0.f, hi_ = 0.f;
    for (int w = 0; w < wid; ++w) { const float e0 = xl[(w * 64 + lane) * 2], e1 = xl[(w * 64 + lane) * 2 + 1]; const float tr = pr * hr - pi * hi_ + e0, ti = pr * hi_ + pi * hr + e1; hr = tr; hi_ = ti; }
    for (int b = 0; b < 6; ++b) { float sr[11], si[11];
#pragma unroll
        for (int k = 0; k < 11; ++k) { const int bc = S5_BC(n0 + b * 11 + k); sr[k] = Sg[(size_t)bc * 256 + off]; si[k] = Sg[(size_t)bc * 256 + off + 64]; }
#pragma unroll
        for (int k = 0; k < 11; ++k) { const int bc = S5_BC(n0 + b * 11 + k);
            HBg[(size_t)bc * 256 + off] = f2bf(hr); HBg[(size_t)bc * 256 + off + 64] = f2bf(hi_);
            const float tr = lre * hr - lim * hi_ + sr[k], ti = lre * hi_ + lim * hr + si[k]; hr = tr; hi_ = ti; } }
#undef S5_BC
    __syncthreads();
}
__device__ __forceinline__ void s5_gemm2_item(const bf16_t* __restrict__ PB, const bf16_t* __restrict__ T2g, const bf16_t* __restrict__ HBg, bf16_t* __restrict__ ZB, unsigned char* ldsB, int g, int cb, int tid) {
    const int wid = tid >> 6, lane = tid & 63, r32 = lane & 31, hi = lane >> 5, bc = cb * 32 + r32;
    s5_stage_z(PB, HBg, ldsB, g, cb, 32, tid);
    __syncthreads();
    f32x16 acc = {};
#pragma unroll
    for (int ks = 0; ks < 32; ++ks) { const bf16x8 a = *(const bf16x8*)(T2g + ((size_t)(wid * 32 + ks) * 64 + lane) * 8), b = *(const bf16x8*)(ldsB + (ks * 64 + lane) * 16); acc = __builtin_amdgcn_mfma_f32_32x32x16_bf16(a, b, acc, 0, 0, 0); }
    if (bc < NCHUNK) {
#pragma unroll
        for (int q = 0; q < 4; ++q) { const int t = 2 * wid + (q >> 1), co = (q & 1) * 8 + 4 * hi;
            u32x2 w; w.x = cvt_pk_bf16(gelu_tanh(acc[4 * q]), gelu_tanh(acc[4 * q + 1])); w.y = cvt_pk_bf16(gelu_tanh(acc[4 * q + 2]), gelu_tanh(acc[4 * q + 3]));
#ifdef EXP_ZERO_S5
            w.x = 0u; w.y = 0u;
#endif
            *(u32x2*)(ZB + (size_t)(bc * 16 + t) * 1024 + g * 16 + co) = w; } }
    __syncthreads();
}

template <int NKS>
__device__ __forceinline__ void s5_load_pieces(const bf16_t* __restrict__ PB, const bf16_t* __restrict__ HB, int it, int tid, bf16x8 (&pre)[NKS / 8]) {
    const int g = it / 17, cb = it % 17;
#pragma unroll
    for (int q = 0; q < NKS / 8; ++q) { const int piece = tid + 512 * q, ks = piece >> 6, ln = piece & 63, r32 = ln & 31, hi = ln >> 5; int bc = cb * 32 + r32; bc = bc < NCHUNK ? bc : NCHUNK - 1;
        const bf16_t* src = ks < 16 ? PB + (size_t)(bc * 16 + ks) * LDE + 4096 + g * 16 + hi * 8 : HB + (size_t)g * NCHUNK * 256 + (size_t)bc * 256 + (ks - 16) * 16 + hi * 8;
        pre[q] = *(const bf16x8*)src; }
}
template <int NKS>
__device__ __forceinline__ void s5_gemm_loop(const bf16_t* __restrict__ PB, const bf16_t* __restrict__ Tb, const bf16_t* __restrict__ HB, float* __restrict__ S, bf16_t* __restrict__ ZB, unsigned char* ldsB, int tid, int Gall, int b0) {
    const int wid = tid >> 6, lane = tid & 63, r32 = lane & 31, hi = lane >> 5; constexpr int NIT = 64 * 17; const int G = Gall - b0;
    bf16x8 pre[NKS / 8]; int it = lbid() >= b0 ? lbid() - b0 : NIT;
    if (it < NIT) s5_load_pieces<NKS>(PB, HB, it, tid, pre);
    for (; it < NIT; it += G) {
        const int g = it / 17, cb = it % 17, bc = cb * 32 + r32; const bf16_t* Tg = Tb + (size_t)g * (256 * NKS * 16);
#pragma unroll
        for (int q = 0; q < NKS / 8; ++q) *(bf16x8*)(ldsB + (tid + 512 * q) * 16) = pre[q];
        bf16x8 a[16];
#pragma unroll
        for (int ks = 0; ks < 16; ++ks) a[ks] = *(const bf16x8*)(Tg + ((size_t)(wid * NKS + ks) * 64 + lane) * 8);
        __syncthreads();
        if (it + G < NIT) s5_load_pieces<NKS>(PB, HB, it + G, tid, pre);
        f32x16 acc = {};
#pragma unroll
        for (int ks = 0; ks < 16; ++ks) acc = __builtin_amdgcn_mfma_f32_32x32x16_bf16(a[ks], *(const bf16x8*)(ldsB + (ks * 64 + lane) * 16), acc, 0, 0, 0);
        if constexpr (NKS == 32) {
#pragma unroll
            for (int ks = 0; ks < 16; ++ks) a[ks] = *(const bf16x8*)(Tg + ((size_t)(wid * NKS + 16 + ks) * 64 + lane) * 8);
#pragma unroll
            for (int ks = 0; ks < 16; ++ks) acc = __builtin_amdgcn_mfma_f32_32x32x16_bf16(a[ks], *(const bf16x8*)(ldsB + ((16 + ks) * 64 + lane) * 16), acc, 0, 0, 0);
        }
        if (bc < NCHUNK) {
            if constexpr (NKS == 16) {
#pragma unroll
                for (int q = 0; q < 4; ++q) { const f32x4 v = {acc[4 * q], acc[4 * q + 1], acc[4 * q + 2], acc[4 * q + 3]}; *(f32x4*)(S + (size_t)g * NCHUNK * 256 + (size_t)bc * 256 + wid * 32 + 8 * q + 4 * hi) = v; }
            } else {
#pragma unroll
                for (int q = 0; q < 4; ++q) { const int t = 2 * wid + (q >> 1), co = (q & 1) * 8 + 4 * hi;
                    u32x2 w; w.x = cvt_pk_bf16(gelu_tanh(acc[4 * q]), gelu_tanh(acc[4 * q + 1])); w.y = cvt_pk_bf16(gelu_tanh(acc[4 * q + 2]), gelu_tanh(acc[4 * q + 3]));
                    *(u32x2*)(ZB + (size_t)(bc * 16 + t) * 1024 + g * 16 + co) = w; }
            }
        }
        __syncthreads();
    }
}

__device__ __forceinline__ void phase_attn(const Params& P, int l, unsigned char* lds) {
    const int i = l >> 1; const bool even = (l & 1) == 0, need_ctx = l < 3; const int G = gridDim.x, tid = ltid(), wid = tid >> 6, lane = tid & 63;
    const bf16_t* PB = (const bf16_t*)(lws(P.ws) + WS_P); bf16_t* OG = (bf16_t*)(lws(P.ws) + WS_OG);
    const int ld = even ? LDE : LDO;
    const int nctx = even ? 8 : (need_ctx ? 16 : 0), nitems = even ? nctx : nctx + 512;
#ifndef NO_DENSE
    const float mfixC = 0.f; const bool fixok = !even && odd_fix_ok(P, i, lane);
    for (int it = lbid(); it < nitems; it += G) {
        int h, q0, base, NT;
        if (it < nctx) { h = it; q0 = SEQ; base = SEQ; NT = 4; } else { const int r = it - nctx; h = r >> 5; q0 = (r & 31) * 256; base = 0; NT = MROWS / 64; }
        const int kcol = even ? 1024 + h * 128 : 2048 + (h >> 2) * 128, vcol = even ? 2048 + h * 128 : 2560 + (h >> 2) * 128;
        if (even) att::attn_body<LDE, att::DenseTiles, false>(PB + (size_t)q0 * ld + h * 128, PB + kcol, PB + vcol, PB + (size_t)q0 * ld + 3072 + h * 128, (bf16_t*)((unsigned char*)OG + (size_t)q0 * 2048 + h * 128), NT, att::DenseTiles{base}, (char*)lds, mfixC);
        else if (fixok) att::attn_body<LDO, att::DenseTiles, true>(PB + (size_t)q0 * ld + h * 128, PB + kcol, PB + vcol, PB + (size_t)q0 * ld + 3072 + h * 128, (bf16_t*)((unsigned char*)OG + (size_t)q0 * 2048 + h * 128), NT, att::DenseTiles{base}, (char*)lds, mfixC);
        else att::attn_body<LDO, att::DenseTiles, false>(PB + (size_t)q0 * ld + h * 128, PB + kcol, PB + vcol, PB + (size_t)q0 * ld + 3072 + h * 128, (bf16_t*)((unsigned char*)OG + (size_t)q0 * 2048 + h * 128), NT, att::DenseTiles{base}, (char*)lds, mfixC);
    }
#endif
    if (even) {
        float* rpbS = (float*)(lds + 8 * 16640);
#ifndef NO_NA
        for (int it = lbid(); it < 256; it += G) {
            const int h = it & 7, rb = it >> 3;
            __syncthreads();
            for (int e = tid; e < 465; e += 512) rpbS[e] = P.na_rpb[(size_t)(i * 8 + h) * 465 + e] * (1.f / att::SCALE);
            __syncthreads();
            att::na_wave(PB, OG, rpbS, rb * 4 + (wid >> 1), (wid & 1) * 32, h, (char*)lds + wid * 16640, lane);
        }
        __syncthreads();
#endif
        const bf16_t* T1 = (const bf16_t*)(lws(P.ws) + WS_T1) + (size_t)i * 64 * 256 * 256; float* S = (float*)(lws(P.ws) + WS_S);
        s5_gemm_loop<16>(PB, T1, nullptr, S, nullptr, lds, tid, G, 8);
    }
}

__device__ __forceinline__ void decode_phase(int ph, int& kind, int& l) {
    l = 0;
    if (ph < 3) { kind = ph; return; }
    int r = ph - 3; if (r >= 7) { r -= 7; l = 1; if (r >= 5) { r -= 5; l = 2; if (r >= 7) { r -= 7; l = 3; } } }
    if ((l & 1) == 0) kind = 3 + r; else kind = (r == 0) ? 3 : (r == 1) ? 10 : (r == 2) ? 4 : (r == 3) ? 8 : 9;
}
__device__ __forceinline__ void run_kind(const Params& P, int kind, int l, unsigned char* lds) {
    LAS unsigned char* ldsl = (LAS unsigned char*)lds;
    unsigned char* ws = lws(P.ws); const int G = gridDim.x;
    const int i = l >> 1; const bool even = (l & 1) == 0;
#ifndef PHMASK
#define PHMASK 0xffff
#endif
    if (!((PHMASK >> kind) & 1)) return;
    switch (kind) {
    case 0: phase_prologue(P, ldsl); break;
    case 1: phase_finalize_mod(P); break;
    case 2: phase_mod0(P); break;
    case 3: {
        const int N = even ? EVEN_IN : ODD_IN; const bf16_t* Bt = even ? (const bf16_t*)(ws + WS_WEVIN + (size_t)i * 6144 * 2048) : (const bf16_t*)(ws + WS_WODIN + (size_t)i * 5120 * 2048);
        pg8::Gemm g{(const bf16_t*)(ws + WS_H), Bt, MROWS, N, DM / 2, DM / 2}; pg8::StaticOrder S; S.init(MROWS, N, G, (int)lbid());
        pg8::EpiBf16 E{(bf16_t*)(ws + WS_P), even ? LDE : LDO, 1.f / WIN_SCALE};
        pg8::gemm_phase<pg8::EpiBf16, pg8::StaticOrder, true, true, true>(ldsl, g, S, E);
    } break;
    case 4: phase_attn(P, l, lds); break;
    case 5: {
        for (int it = lbid(); it < 128; it += G) { const int g = it >> 1, dir = it & 1;
            s5_scan_item((const float*)(ws + WS_S) + (size_t)g * NCHUNK * 256, (bf16_t*)(ws + WS_HB) + (size_t)g * NCHUNK * 256, (const float*)(ws + WS_LAM) + (size_t)(i * 64 + g) * 256, dir, (float*)lds, ltid()); }
    } break;
    case 6: {
        const bf16_t* T2 = (const bf16_t*)(ws + WS_T2) + (size_t)i * 64 * 256 * 512;
        s5_gemm_loop<32>((const bf16_t*)(ws + WS_P), T2, (const bf16_t*)(ws + WS_HB), nullptr, (bf16_t*)(ws + WS_ZB), lds, ltid(), G, 0);
    } break;
    case 7: {
        pg8::Gemm g{(const bf16_t*)(ws + WS_ZB), (const bf16_t*)(ws + WS_WGLU) + (size_t)i * 1024 * 1024, MROWS, 1024, 1024, 1024}; pg8::StaticOrder S; S.init(MROWS, 1024, G, (int)lbid());
        pg8::EpiGlu E{(const bf16_t*)(ws + WS_ZB), (const bf16_t*)(ws + WS_P), P.s5_glu_b + i * 1024, (bf16_t*)(ws + WS_OG)};
        pg8::gemm_phase<pg8::EpiGlu, pg8::StaticOrder, true, true>(ldsl, g, S, E);
    } break;
    case 8: {
        const bf16_t* Bt = even ? (const bf16_t*)(ws + WS_WEVOUT + (size_t)i * 2048 * 2048) : (const bf16_t*)(ws + WS_WODOUT + (size_t)i * 2048 * 2048);
        {   pg8::Gemm g{(const bf16_t*)(ws + WS_OG), Bt, SEQ, DM, DM / 2, DM / 2}; pg8::StaticOrder S; S.init(SEQ, DM, G, (int)lbid());
            float* X = (float*)(ws + WS_X); const float* MOD = (const float*)(ws + WS_MOD);
            pg8::EpiOut E{l == 0 ? P.x : X, X, X, MOD + (size_t)((l * 2 + 0) * 3 + 2) * 2048, MOD + (size_t)((l * 2 + 0) * 3 + 2) * 2048, DN_ALPHA, 1.f / (OG_SCALE * WOUT_SCALE)};
            pg8::gemm_phase<pg8::EpiOut, pg8::StaticOrder, true, true, true>(ldsl, g, S, E); }
    } break;
    case 9: phase_ln(P, l); break;
    case 10: phase_qknorm(P, i); break;
    case 11: {
        const unsigned char* Bt = even ? ws + WS_WEVOUT + (size_t)i * 2048 * 2048 : ws + WS_WODOUT + (size_t)i * 2048 * 2048;
        const int b = lbid(), ks = b >> 3;
        pg8::Gemm g{(const bf16_t*)(ws + WS_OG + (size_t)SEQ * DM + ks * 512), (const bf16_t*)(Bt + ks * 512), 256, DM, 256, DM / 2}; pg8::OneUnit S{b & 7, b < 32};
        pg8::EpiPart E{(float*)(ws + WS_S) + (size_t)ks * 256 * 2048, 1.f / (OG_SCALE * WOUT_SCALE)};
        pg8::gemm_phase<pg8::EpiPart, pg8::OneUnit, false, true, true>(ldsl, g, S, E);
    } break;
    case 12: case 13: case 14: case 15: {
        const int b0 = kind == 12 ? 24 : kind == 13 ? 132 : kind == 14 ? 148 : 24;
        if (lbid() >= b0) convert_seg(P, kind - 11, (lbid() - b0) * 8 + (ltid() >> 6), (G - b0) * 8, (LAS float*)(ldsl + (ltid() >> 6) * 16640), ltid() & 63);
    } break;
    default: break;
    }
}

#define RLX_AGENT __ATOMIC_RELAXED, __HIP_MEMORY_SCOPE_AGENT
#define XB_TMO      128
#define XB_XCNT(j)  (256  + 64 * (j))
#define XB_XSUB(j)  (1280 + 64 * (j))
#define XB_XGEN(j)  (2304 + 64 * (j))
#define XB_TOP      3328
#define XB_TOPGEN   3392
#define XCD_BAR_WORDS 3456
#define XB_SPIN_CAP (1u << 18)

__device__ __forceinline__ unsigned xb_ld(unsigned* p)              { return __hip_atomic_load(p, __ATOMIC_RELAXED, __HIP_MEMORY_SCOPE_AGENT); }
__device__ __forceinline__ unsigned xb_add(unsigned* p, unsigned v) { return __hip_atomic_fetch_add(p, v, __ATOMIC_RELAXED, __HIP_MEMORY_SCOPE_AGENT); }
__device__ __forceinline__ unsigned xb_xcc_id() { return (unsigned)__builtin_amdgcn_s_getreg((3 << 11) | 20) & 0xFu; }
#define XB_SPIN(cond, bar) do { unsigned _sp = 0; while (cond) { __builtin_amdgcn_s_sleep(1); \
    if ((++_sp & 255u) == 0u) { if (xb_ld(&(bar)[XB_TMO])) break; if (_sp > XB_SPIN_CAP) { atomicAdd(&(bar)[XB_TMO], 1u); break; } } } } while (0)

struct XcdBarrier {
    unsigned* bar; unsigned x;
    volatile LAS unsigned* st;
};

__device__ __forceinline__ XcdBarrier xcd_barrier_post(unsigned* bar, volatile LAS unsigned* st) {
    XcdBarrier b; b.bar = bar; b.x = xb_xcc_id(); b.st = st;
    if (ltid() == 0) (void)xb_add(&bar[XB_XCNT(b.x)], 1u);
    return b;
}
__device__ __forceinline__ void xcd_barrier_complete(unsigned* bar, unsigned x, unsigned& nloc, unsigned& nx) {
    const unsigned G = gridDim.x * gridDim.y * gridDim.z;
    unsigned sum, cnt, mine, sp = 0u;
    for (;;) {
        sum = 0u; cnt = 0u; mine = 0u;
#pragma unroll
        for (unsigned j = 0; j < 16; ++j) { const unsigned c = xb_ld(&bar[XB_XCNT(j)]); sum += c; cnt += (c > 0u) ? 1u : 0u; mine = (j == x) ? c : mine; }
        if (sum == G) break;
        __builtin_amdgcn_s_sleep(1);
        if ((++sp & 255u) == 0u) { if (xb_ld(&bar[XB_TMO])) break; if (sp > XB_SPIN_CAP) { atomicAdd(&bar[XB_TMO], 1u); break; } }
    }
    nloc = mine > 0u ? mine : 1u; nx = cnt > 0u ? cnt : 1u;
}

__device__ __forceinline__ void xcd_barrier(const XcdBarrier& b) {
    asm volatile("s_waitcnt vmcnt(0)" ::: "memory");
    __syncthreads();
    if (ltid() == 0) {
        unsigned* bar = b.bar;
        __builtin_amdgcn_s_waitcnt(0);
        unsigned nloc = b.st[0], nx = b.st[1];
        if (nloc == 0u) { xcd_barrier_complete(bar, b.x, nloc, nx); b.st[0] = nloc; b.st[1] = nx; }
        const unsigned old = xb_add(&bar[XB_XSUB(b.x)], 1u);
        const unsigned gen = old / nloc;
        if (old + 1u == (gen + 1u) * nloc) {
            __builtin_amdgcn_fence(__ATOMIC_RELEASE, "agent");
            asm volatile("s_waitcnt vmcnt(0)" ::: "memory");
            const unsigned og = xb_add(&bar[XB_TOP], 1u);
            const unsigned tg = og / nx;
            if (og + 1u == (tg + 1u) * nx) xb_add(&bar[XB_TOPGEN], 1u);
            else XB_SPIN(xb_ld(&bar[XB_TOPGEN]) == tg, bar);
            __builtin_amdgcn_fence(__ATOMIC_ACQUIRE, "agent");
            xb_add(&bar[XB_XGEN(b.x)], 1u);
            asm volatile("s_waitcnt vmcnt(0)" ::: "memory");
        } else {
            XB_SPIN(xb_ld(&bar[XB_XGEN(b.x)]) == gen, bar);
            __builtin_amdgcn_fence(__ATOMIC_ACQUIRE, "agent");
            asm volatile("s_waitcnt vmcnt(0)" ::: "memory");
        }
    }
    __syncthreads();
}

__global__ void __launch_bounds__(512, 2) mega_fwd(Params P) {
    extern __shared__ __attribute__((aligned(16))) unsigned char lds[];
    cg::grid_group grid = cg::this_grid();
    volatile LAS unsigned* misc = (volatile LAS unsigned*)((LAS unsigned char*)lds + LDS_BYTES - 64);
    if (threadIdx.x < 16) misc[threadIdx.x] = 0u;
    __syncthreads();
    XcdBarrier bar = xcd_barrier_post((unsigned*)P.ws, misc);
#define GRID_BAR(ph) do { if ((ph) == P.ph_lo) grid.sync(); else xcd_barrier(bar); } while (0)
    for (int ph = P.ph_lo; ph < P.ph_hi; ++ph) {
        int kind, l; decode_phase(ph, kind, l);
        const int kind2 = (kind == 8 && l < 3) ? 11 : (kind == 3 && l == 0) ? 12 : (kind == 7 && l == 0) ? 13 : (kind == 3 && l == 1) ? 14 : (kind == 3 && l == 2) ? 15 : -1;
        const int nsub = kind2 >= 0 ? 2 : 1;
        for (int sub = 0; sub < nsub; ++sub) run_kind(P, sub == 0 ? kind : kind2, l, lds);
        if (ph + 1 < P.ph_hi) GRID_BAR(ph);
    }
}

#ifndef MK_SPLIT
#define MK_SPLIT 0
#endif
extern "C" void kernel_launch(void* const* d_in, const int* in_sizes, int n_in, void* d_out, int out_size, void* d_ws, size_t ws_size, hipStream_t stream) {
    static int grid = 0;
    if (grid == 0) {
        if (n_in != 25 || out_size != SEQ * DM || ws_size < WS_END) { fprintf(stderr, "kernel_launch: unexpected shapes (n_in %d out %d ws %zu)\n", n_in, out_size, ws_size); grid = -1; return; }
        int dev = 0, cus = 0, per_cu = 0;
        hipGetDevice(&dev); hipDeviceGetAttribute(&cus, hipDeviceAttributeMultiprocessorCount, dev);
        if (hipFuncSetAttribute((const void*)mega_fwd, hipFuncAttributeMaxDynamicSharedMemorySize, LDS_BYTES) != hipSuccess) { fprintf(stderr, "kernel_launch: hipFuncSetAttribute failed\n"); grid = -1; return; }
        if (hipOccupancyMaxActiveBlocksPerMultiprocessor(&per_cu, (const void*)mega_fwd, 512, LDS_BYTES) != hipSuccess || per_cu < 1) { fprintf(stderr, "kernel_launch: occupancy query says %d\n", per_cu); grid = -1; return; }
        grid = cus;
        fprintf(stderr, "kernel_launch: grid %d (per_cu %d)\n", grid, per_cu);
    }
    if (grid < 0) return;
    if (hipMemsetAsync(d_ws, 0, 16384, stream) != hipSuccess) { fprintf(stderr, "kernel_launch: memset failed\n"); return; }
    Params p{};
    const float** pp = (const float**)&p;
    for (int k = 0; k < 25; ++k) pp[k] = (const float*)d_in[k];
    p.out = (float*)d_out; p.ws = (unsigned char*)d_ws;
#if MK_SPLIT
    for (int ph = 0; ph < NPH; ++ph) { p.ph_lo = ph; p.ph_hi = ph + 1; void* args[] = {&p};
        hipError_t e = hipLaunchCooperativeKernel((void*)mega_fwd, dim3(grid), dim3(512), args, LDS_BYTES, stream);
        if (e != hipSuccess) { fprintf(stderr, "launch %d failed: %s\n", ph, hipGetErrorString(e)); break; } }
#else
    p.ph_lo = 0; p.ph_hi = NPH; void* args[] = {&p};
    hipError_t e = hipLaunchCooperativeKernel((void*)mega_fwd, dim3(grid), dim3(512), args, LDS_BYTES, stream);
    if (e != hipSuccess) fprintf(stderr, "cooperative launch failed: %s (grid %d)\n", hipGetErrorString(e), grid);
#endif
}
```

```cpp
#include <hip/hip_runtime.h>
#include <hip/hip_cooperative_groups.h>
#include <cstdio>
#include <cstdint>
namespace cg = cooperative_groups;

#define LAS __attribute__((address_space(3)))
typedef unsigned short bf16_t;
typedef short bf16x8 __attribute__((ext_vector_type(8)));
typedef short s16x4 __attribute__((ext_vector_type(4)));
typedef float f32x4 __attribute__((ext_vector_type(4)));
typedef float f32x16 __attribute__((ext_vector_type(16)));
typedef unsigned u32x4 __attribute__((ext_vector_type(4)));
typedef unsigned u32x2 __attribute__((ext_vector_type(2)));

__device__ __forceinline__ unsigned cvt_pk_bf16(float lo, float hi) { unsigned r; asm volatile("v_cvt_pk_bf16_f32 %0, %1, %2" : "=v"(r) : "v"(lo), "v"(hi)); return r; }
__device__ __forceinline__ float bf_lo(unsigned w) { return __uint_as_float(w << 16); }
__device__ __forceinline__ float bf_hi(unsigned w) { return __uint_as_float(w & 0xffff0000u); }
__device__ __forceinline__ float bf2f(bf16_t b) { return __uint_as_float((unsigned)b << 16); }
__device__ __forceinline__ bf16_t f2bf(float f) { return (bf16_t)(cvt_pk_bf16(f, 0.f) & 0xffffu); }
__device__ __forceinline__ unsigned pack4_fp8(f32x4 h) { int w = __builtin_amdgcn_cvt_pk_fp8_f32(h[0], h[1], 0, false); w = __builtin_amdgcn_cvt_pk_fp8_f32(h[2], h[3], w, true); return (unsigned)w; }
__device__ __forceinline__ unsigned pack4_fp8_sat(f32x4 h) {
    h[0] = __builtin_amdgcn_fmed3f(h[0], -448.f, 448.f); h[1] = __builtin_amdgcn_fmed3f(h[1], -448.f, 448.f); h[2] = __builtin_amdgcn_fmed3f(h[2], -448.f, 448.f); h[3] = __builtin_amdgcn_fmed3f(h[3], -448.f, 448.f);
    return pack4_fp8(h); }
__device__ __forceinline__ float sigmoidf_(float v) { return __builtin_amdgcn_rcpf(1.f + __expf(-v)); }
__device__ __forceinline__ float siluf_(float v) { return v * sigmoidf_(v); }
__device__ __forceinline__ float gelu_tanh(float v) { const float z = 0.7978845608028654f * (v + 0.044715f * v * v * v); return v * sigmoidf_(2.f * z); }
__device__ __forceinline__ float wave_sum(float v) {
#pragma unroll
    for (int o = 1; o < 64; o <<= 1) v += __shfl_xor(v, o);
    return v;
}

__device__ __forceinline__ int ltid() { int t = threadIdx.x; asm volatile("" : "+v"(t)); return t; }
__device__ __forceinline__ int lbid() { int b = blockIdx.x; asm volatile("" : "+s"(b)); return b; }
__device__ __forceinline__ unsigned char* lws(unsigned char* w) { asm volatile("" : "+s"(w)); return w; }

constexpr int DM = 2048, SEQ = 8192, CTXL = 256, MROWS = SEQ + CTXL;
constexpr int EVEN_IN = 6144, ODD_IN = 5120;
constexpr int LDE = EVEN_IN + 128, LDO = ODD_IN + 128;
constexpr float DN_ALPHA = 1.6817928305074290f;
constexpr float LN_EPS = 1e-6f, RMS_EPS = 1e-6f;
constexpr float OG_SCALE = 4.f, WIN_SCALE = 32.f, WOUT_SCALE = 64.f;
constexpr int NCHUNK = MROWS / 16;

namespace pg8 {
#define PG8_LAS __attribute__((address_space(3)))
typedef unsigned short bf16_t;
typedef short bf16x8 __attribute__((ext_vector_type(8)));
typedef float f32x4 __attribute__((ext_vector_type(4)));
typedef unsigned u32x4 __attribute__((ext_vector_type(4)));
constexpr int BM = 256, BK = 64, HALF = 128, HTB = HALF * BK * 2  , STAGE_BYTES = 8 * HTB, NXCD = 8, WGM = 8;

__host__ __device__ __forceinline__ int lds_byte(int r, int c) { const int st = (r >> 4) * 2 + (c >> 5), rr = r & 15, cc = c & 31, ob = rr * 64 + cc * 2; return st * 1024 + (ob ^ (((ob >> 9) & 1) << 5)); }
__host__ __device__ __forceinline__ void stage_rc(int b, int& R, int& C) { const int st = b / 1024, sb = b % 1024, swz = sb ^ (((sb >> 9) & 1) << 5); R = (st >> 1) * 16 + swz / 64; C = (st & 1) * 32 + (swz % 64) / 2; }
__host__ __device__ __forceinline__ int perm32(int rho) { const int n = rho >> 4, i = rho & 15; return 8 * (i >> 2) + 4 * n + (i & 3); }

struct Unit { int pm, pn; };
struct Gemm { const bf16_t* A; const bf16_t* Bt; int M, N, K, ld; };

struct StaticOrder {
    int nM, nN, nwg, G, c;
    __host__ __device__ void init(int M, int N, int G_, int c_) { nM = M / BM; nN = N / BM; nwg = nM * nN; G = G_; c = c_; }
    __host__ __device__ bool next(int i, Unit& u) const {
        const long L = (long)i * G + c; if (L >= nwg) return false;
        int wgid = (int)L; { const int q = nwg / NXCD, r = nwg % NXCD, xcd = wgid % NXCD, off = wgid / NXCD; wgid = (xcd < r ? xcd * (q + 1) : r * (q + 1) + (xcd - r) * q) + off; }
        const int nig = WGM * nN, gid = wgid / nig, fm = gid * WGM, gsz = (nM - fm) < WGM ? (nM - fm) : WGM;
        u.pm = fm + ((wgid % nig) % gsz); u.pn = (wgid % nig) / gsz; return true;
    }
    __device__ __forceinline__ void a_ready(const Unit&) const {}
    __device__ __forceinline__ void done(const Unit&) const {}
};

struct EpiBf16 {
    static constexpr bool PERM = true, AFTER_DRAIN = false;
    bf16_t* O; int ldc; float sc;
    __device__ __forceinline__ void operator()(const f32x4 (&acc)[2][2][4][2], const Unit& u, int wr, int wc, int fr, int fq) const {
        asm volatile("" : "+v"(fr), "+v"(fq));
        const int row0 = u.pm * BM + wr * 64 + fr; const int col0 = u.pn * BM + wc * 32 + 8 * fq;
#pragma unroll
        for (int ai = 0; ai < 2; ++ai)
#pragma unroll
            for (int m = 0; m < 4; ++m) { bf16_t* rowp = O + (size_t)(row0 + ai * HALF + m * 16) * ldc + col0;
#pragma unroll
                for (int bj = 0; bj < 2; ++bj) { const f32x4 v0 = acc[ai][bj][m][0] * sc, v1 = acc[ai][bj][m][1] * sc;
                    u32x4 w; w.x = ::cvt_pk_bf16(v0[0], v0[1]); w.y = ::cvt_pk_bf16(v0[2], v0[3]); w.z = ::cvt_pk_bf16(v1[0], v1[1]); w.w = ::cvt_pk_bf16(v1[2], v1[3]);
                    *(u32x4*)(rowp + bj * HALF) = w; } }
    }
};
struct EpiGlu {
    static constexpr bool PERM = true, AFTER_DRAIN = false;
    const bf16_t* ZB; const bf16_t* P; const float* bias; bf16_t* OG;
    __device__ __forceinline__ void operator()(const f32x4 (&acc)[2][2][4][2], const Unit& u, int wr, int wc, int fr, int fq) const {
        asm volatile("" : "+v"(fr), "+v"(fq));
        const int row0 = u.pm * BM + wr * 64 + fr; const int col0 = u.pn * BM + wc * 32 + 8 * fq;
        f32x4 bv[2][2];
#pragma unroll
        for (int bj = 0; bj < 2; ++bj)
#pragma unroll
            for (int n = 0; n < 2; ++n) bv[bj][n] = *(const f32x4*)(bias + col0 + bj * HALF + 4 * n);
#pragma unroll
        for (int ai = 0; ai < 2; ++ai)
#pragma unroll
            for (int m = 0; m < 4; ++m) { const size_t row = (size_t)(row0 + ai * HALF + m * 16);
#pragma unroll
                for (int bj = 0; bj < 2; ++bj) { const int col = col0 + bj * HALF;
                    const u32x4 zw = *(const u32x4*)(ZB + row * 1024 + col); const u32x4 gw = *(const u32x4*)(P + row * LDE + 5120 + col);
                    const f32x4 v0 = acc[ai][bj][m][0] + bv[bj][0], v1 = acc[ai][bj][m][1] + bv[bj][1];
                    float o[8];
#pragma unroll
                    for (int e = 0; e < 4; ++e) { const unsigned z = zw[e], g = gw[e]; const float a0 = e < 2 ? v0[2 * e] : v1[2 * e - 4], a1 = e < 2 ? v0[2 * e + 1] : v1[2 * e - 3];
                        const float g0 = ::bf_lo(g), g1 = ::bf_hi(g);
                        o[2 * e] = ::bf_lo(z) * g0 * __builtin_amdgcn_rcpf((1.f + __expf(-a0)) * (1.f + __expf(-g0))); o[2 * e + 1] = ::bf_hi(z) * g1 * __builtin_amdgcn_rcpf((1.f + __expf(-a1)) * (1.f + __expf(-g1))); }
                    u32x2 w; w.x = ::pack4_fp8_sat((f32x4){o[0], o[1], o[2], o[3]} * OG_SCALE); w.y = ::pack4_fp8_sat((f32x4){o[4], o[5], o[6], o[7]} * OG_SCALE);
                    *(u32x2*)((unsigned char*)OG + row * 2048 + 1024 + col) = w; } }
    }
};
struct EpiOut {
    static constexpr bool PERM = true, AFTER_DRAIN = false;
    const float* srcL; const float* srcC; float* X; const float* gtL; const float* gtC; float alpha, sc;
    __device__ __forceinline__ void operator()(const f32x4 (&acc)[2][2][4][2], const Unit& u, int wr, int wc, int fr, int fq) const {
        asm volatile("" : "+v"(fr), "+v"(fq));
        const int row0 = u.pm * BM + wr * 64 + fr; const int col0 = u.pn * BM + wc * 32 + 8 * fq;
        const float* src = u.pm < 32 ? srcL : srcC; const float* gt = u.pm < 32 ? gtL : gtC;
        f32x4 gv[2][2];
#pragma unroll
        for (int bj = 0; bj < 2; ++bj)
#pragma unroll
            for (int n = 0; n < 2; ++n) gv[bj][n] = *(const f32x4*)(gt + col0 + bj * HALF + 4 * n) * sc;
#pragma unroll
        for (int ai = 0; ai < 2; ++ai)
#pragma unroll
            for (int m = 0; m < 4; ++m) { const size_t off = (size_t)(row0 + ai * HALF + m * 16) * 2048 + col0;
#pragma unroll
                for (int bj = 0; bj < 2; ++bj)
#pragma unroll
                    for (int n = 0; n < 2; ++n) { const f32x4 xs = *(const f32x4*)(src + off + bj * HALF + 4 * n);
                        *(f32x4*)(X + off + bj * HALF + 4 * n) = xs * alpha + gv[bj][n] * acc[ai][bj][m][n]; } }
    }
};

struct EpiPart {
    static constexpr bool PERM = true, AFTER_DRAIN = false;
    float* O; float sc;
    __device__ __forceinline__ void operator()(const f32x4 (&acc)[2][2][4][2], const Unit& u, int wr, int wc, int fr, int fq) const {
        asm volatile("" : "+v"(fr), "+v"(fq));
        const int row0 = u.pm * BM + wr * 64 + fr; const int col0 = u.pn * BM + wc * 32 + 8 * fq;
#pragma unroll
        for (int ai = 0; ai < 2; ++ai)
#pragma unroll
            for (int m = 0; m < 4; ++m) { const size_t off = (size_t)(row0 + ai * HALF + m * 16) * 2048 + col0;
#pragma unroll
                for (int bj = 0; bj < 2; ++bj)
#pragma unroll
                    for (int n = 0; n < 2; ++n) *(f32x4*)(O + off + bj * HALF + 4 * n) = acc[ai][bj][m][n] * sc; }
    }
};
struct OneUnit { int pn; bool valid;
    __device__ __forceinline__ bool next(int i, Unit& u) const { u.pm = 0; u.pn = pn; return i == 0 && valid; }
    __device__ __forceinline__ void a_ready(const Unit&) const {}
    __device__ __forceinline__ void done(const Unit&) const {}
};

template <class Epi, class Sched, bool ALIGN_EPI = false, bool SP2 = false, bool FP8 = false>
__device__ __forceinline__ void gemm_phase(PG8_LAS unsigned char* lds, const Gemm g, const Sched& S, const Epi& E) {
    const int tid = ltid(), wid = __builtin_amdgcn_readfirstlane(tid >> 6), lane = tid & 63, wr = wid >> 2, wc = wid & 3, fr = lane & 15, fq = lane >> 4;
    const int K = g.K, nt = K / BK;
    unsigned voffA[2], voffB[2];
#pragma unroll
    for (int i = 0; i < 2; ++i) { int R, C; stage_rc(tid * 16 + i * 8192, R, C); const int Rb = Epi::PERM ? ((R & ~31) + perm32(R & 31)) : R;
        voffA[i] = (unsigned)(R * g.ld + C) * 2u; voffB[i] = (unsigned)(Rb * g.ld + C) * 2u; }
    const size_t kstep = (size_t)(BK * 2);
    const size_t hstep = (size_t)HALF * g.ld * 2;
    const size_t tstep = 2 * hstep;
    const unsigned ldsw = (unsigned)wid * 1024u;
    const int aoff = lds_byte(wr * 64 + fr, fq * 8), boff = lds_byte(wc * 32 + fr, fq * 8);
#define PG8_SA(b, h) (((b) * 2 + (h)) * HTB)
#define PG8_SB(b, h) ((4 + (b) * 2 + (h)) * HTB)
#define PG8_STAGE(bufoff, gbase, voff) do { _Pragma("unroll") for (int _i = 0; _i < 2; ++_i) \
        __builtin_amdgcn_global_load_lds((const unsigned*)((const char*)(gbase) + (voff)[_i]), (PG8_LAS unsigned*)(lds + (bufoff) + ldsw + _i * 8192), 16, 0, 0); } while (0)
#define PG8_LDA(dst, b, h) do { if constexpr (FP8) { _Pragma("unroll") for (int m = 0; m < 4; ++m) dst##8[m] = __builtin_shufflevector(*(const PG8_LAS i32x4_*)(lds + PG8_SA(b, h) + aoff + m * 2048), *(const PG8_LAS i32x4_*)(lds + PG8_SA(b, h) + aoff + m * 2048 + 1024), 0, 1, 2, 3, 4, 5, 6, 7); } \
        else { _Pragma("unroll") for (int m = 0; m < 4; ++m) _Pragma("unroll") for (int k = 0; k < 2; ++k) dst[m][k] = *(const PG8_LAS bf16x8*)(lds + PG8_SA(b, h) + aoff + m * 2048 + k * 1024); } } while (0)
#define PG8_LDB(dst, b, h) do { if constexpr (FP8) { _Pragma("unroll") for (int n = 0; n < 2; ++n) dst##8[n] = __builtin_shufflevector(*(const PG8_LAS i32x4_*)(lds + PG8_SB(b, h) + boff + n * 2048), *(const PG8_LAS i32x4_*)(lds + PG8_SB(b, h) + boff + n * 2048 + 1024), 0, 1, 2, 3, 4, 5, 6, 7); } \
        else { _Pragma("unroll") for (int n = 0; n < 2; ++n) _Pragma("unroll") for (int k = 0; k < 2; ++k) dst[n][k] = *(const PG8_LAS bf16x8*)(lds + PG8_SB(b, h) + boff + n * 2048 + k * 1024); } } while (0)
#define PG8_MMA(ai, bj, At, Bt) do { __builtin_amdgcn_s_setprio(1); _Pragma("unroll") for (int m = 0; m < 4; ++m) _Pragma("unroll") for (int n = 0; n < 2; ++n) { \
        if constexpr (FP8) asm volatile("v_mfma_scale_f32_16x16x128_f8f6f4 %0, %1, %2, %0, %3, %3 op_sel_hi:[0,0,0]" : "+v"(acc[ai][bj][m][n]) : "v"(Bt##8[n]), "v"(At##8[m]), "v"(one_scale)); \
        else { _Pragma("unroll") for (int k = 0; k < 2; ++k) acc[ai][bj][m][n] = __builtin_amdgcn_mfma_f32_16x16x32_bf16(Bt[n][k], At[m][k], acc[ai][bj][m][n], 0, 0, 0); } } \
        __builtin_amdgcn_s_setprio(0); } while (0)
#define PG8_WAIT_V(n) asm volatile("s_waitcnt vmcnt(" #n ")" ::: "memory")
#define PG8_WAIT_L(n) asm volatile("s_waitcnt lgkmcnt(" #n ")" ::: "memory")
#define PG8_BAR __builtin_amdgcn_s_barrier()
#define PG8_SCHED __builtin_amdgcn_sched_barrier(0)
    Unit cur, nxt; int ui = 0;
    if (!S.next(0, cur)) return;
    f32x4 acc[2][2][4][2];
#pragma unroll
    for (int a = 0; a < 2; ++a)
#pragma unroll
        for (int b = 0; b < 2; ++b)
#pragma unroll
            for (int m = 0; m < 4; ++m)
#pragma unroll
                for (int n = 0; n < 2; ++n) acc[a][b][m][n] = (f32x4){0.f, 0.f, 0.f, 0.f};
    typedef int i32x4_ __attribute__((ext_vector_type(4))); typedef int i32x8_ __attribute__((ext_vector_type(8)));
    bf16x8 At[4][2], B0[2][2], B1[2][2]; i32x8_ At8[4], B08[2], B18[2]; const int one_scale = 0x7F7F7F7F;
    const char* cA = (const char*)g.A + (size_t)cur.pm * tstep; const char* cB = (const char*)g.Bt + (size_t)cur.pn * tstep;
    S.a_ready(cur);
    if constexpr (SP2) {
        PG8_STAGE(PG8_SB(0, 0), cB, voffB); PG8_STAGE(PG8_SB(0, 1), cB + hstep, voffB); PG8_STAGE(PG8_SA(0, 0), cA, voffA); PG8_STAGE(PG8_SA(0, 1), cA + hstep, voffA);
        if (wr == 1) PG8_BAR;
        PG8_WAIT_V(2); PG8_BAR;
        PG8_STAGE(PG8_SB(1, 0), cB + kstep, voffB); PG8_STAGE(PG8_SA(1, 0), cA + kstep, voffA); PG8_STAGE(PG8_SB(1, 1), cB + hstep + kstep, voffB);
        PG8_WAIT_V(6); PG8_BAR;
    } else {
        PG8_STAGE(PG8_SB(0, 0), cB, voffB); PG8_STAGE(PG8_SA(0, 0), cA, voffA); PG8_STAGE(PG8_SB(0, 1), cB + hstep, voffB); PG8_STAGE(PG8_SA(0, 1), cA + hstep, voffA);
        if (wr == 1) PG8_BAR;
        PG8_WAIT_V(4); PG8_BAR;
        PG8_STAGE(PG8_SB(1, 0), cB + kstep, voffB); PG8_STAGE(PG8_SA(1, 0), cA + kstep, voffA); PG8_STAGE(PG8_SB(1, 1), cB + hstep + kstep, voffB);
        PG8_WAIT_V(6); PG8_BAR;
    }
    for (;;) {
        const bool has_next = S.next(ui + 1, nxt);
        const char* nA = has_next ? (const char*)g.A + (size_t)nxt.pm * tstep : cA; const char* nB = has_next ? (const char*)g.Bt + (size_t)nxt.pn * tstep : cB;
        for (int t = 0; t < nt; t += 2) {
            const bool last = (t == nt - 2);
            const char* a1 = cA + (size_t)(t + 1) * kstep;
            const char* a2 = last ? nA : cA + (size_t)(t + 2) * kstep; const char* b2 = last ? nB : cB + (size_t)(t + 2) * kstep;
            const char* a3 = a2 + kstep; const char* b3 = b2 + kstep;
            if (last && has_next) S.a_ready(nxt);
            if constexpr (SP2) {
            PG8_LDB(B0, 0, 0); PG8_LDB(B1, 0, 1); PG8_SCHED; PG8_LDA(At, 0, 0); PG8_STAGE(PG8_SA(1, 1), a1 + hstep, voffA);
            PG8_WAIT_V(8); PG8_WAIT_L(0); PG8_BAR; PG8_MMA(0, 0, At, B0); PG8_MMA(0, 1, At, B1); PG8_BAR; PG8_SCHED;
            PG8_LDA(At, 0, 1); PG8_STAGE(PG8_SB(0, 0), b2, voffB); PG8_STAGE(PG8_SB(0, 1), b2 + hstep, voffB); PG8_STAGE(PG8_SA(0, 0), a2, voffA);
            PG8_WAIT_V(8); PG8_WAIT_L(0); PG8_BAR; PG8_MMA(1, 0, At, B0); PG8_MMA(1, 1, At, B1); PG8_BAR; PG8_SCHED;
            PG8_LDB(B0, 1, 0); PG8_LDB(B1, 1, 1); PG8_SCHED; PG8_LDA(At, 1, 0); PG8_STAGE(PG8_SA(0, 1), a2 + hstep, voffA);
            PG8_WAIT_V(8); PG8_WAIT_L(0); PG8_BAR; PG8_MMA(0, 0, At, B0); PG8_MMA(0, 1, At, B1); PG8_BAR; PG8_SCHED;
            PG8_LDA(At, 1, 1); PG8_STAGE(PG8_SB(1, 0), b3, voffB); PG8_STAGE(PG8_SB(1, 1), b3 + hstep, voffB); PG8_STAGE(PG8_SA(1, 0), a3, voffA);
            PG8_WAIT_V(8); PG8_WAIT_L(0); PG8_BAR; PG8_MMA(1, 0, At, B0); PG8_MMA(1, 1, At, B1); PG8_BAR; PG8_SCHED;
            } else {
            PG8_LDB(B0, 0, 0); PG8_SCHED; PG8_LDA(At, 0, 0); PG8_STAGE(PG8_SA(1, 1), a1 + hstep, voffA);
            PG8_WAIT_L(8); PG8_BAR; PG8_WAIT_L(0); PG8_MMA(0, 0, At, B0); PG8_BAR; PG8_SCHED;
            PG8_LDB(B1, 0, 1); PG8_STAGE(PG8_SB(0, 0), b2, voffB);
            PG8_BAR; PG8_WAIT_L(0); PG8_MMA(0, 1, At, B1); PG8_BAR;
            PG8_LDA(At, 0, 1); PG8_STAGE(PG8_SA(0, 0), a2, voffA);
            PG8_BAR; PG8_WAIT_L(0); PG8_MMA(1, 0, At, B0); PG8_BAR; PG8_SCHED;
            PG8_STAGE(PG8_SB(0, 1), b2 + hstep, voffB);
            PG8_WAIT_V(6); PG8_BAR; PG8_MMA(1, 1, At, B1); PG8_BAR;
            PG8_LDB(B0, 1, 0); PG8_SCHED; PG8_LDA(At, 1, 0); PG8_STAGE(PG8_SA(0, 1), a2 + hstep, voffA);
            PG8_WAIT_L(8); PG8_BAR; PG8_WAIT_L(0); PG8_MMA(0, 0, At, B0); PG8_BAR; PG8_SCHED;
            PG8_LDB(B1, 1, 1); PG8_STAGE(PG8_SB(1, 0), b3, voffB);
            PG8_BAR; PG8_WAIT_L(0); PG8_MMA(0, 1, At, B1); PG8_BAR;
            PG8_LDA(At, 1, 1); PG8_STAGE(PG8_SA(1, 0), a3, voffA);
            PG8_BAR; PG8_WAIT_L(0); PG8_MMA(1, 0, At, B0); PG8_BAR; PG8_SCHED;
            PG8_STAGE(PG8_SB(1, 1), b3 + hstep, voffB);
            PG8_WAIT_V(6); PG8_BAR; PG8_MMA(1, 1, At, B1); PG8_BAR;
            }
        }
        if constexpr (ALIGN_EPI) { if (wr == 0) PG8_BAR; }
        if constexpr (!Epi::AFTER_DRAIN) { E(acc, cur, wr, wc, fr, fq); S.done(cur); }
        if (!has_next) break;
#pragma unroll
        for (int a = 0; a < 2; ++a)
#pragma unroll
            for (int b = 0; b < 2; ++b)
#pragma unroll
                for (int m = 0; m < 4; ++m)
#pragma unroll
                    for (int n = 0; n < 2; ++n) acc[a][b][m][n] = (f32x4){0.f, 0.f, 0.f, 0.f};
        cur = nxt; cA = nA; cB = nB; ++ui;
        if constexpr (ALIGN_EPI) { if (wr == 1) PG8_BAR; }
    }
    PG8_WAIT_V(0);
    if constexpr (!ALIGN_EPI) { if (wr == 0) PG8_BAR; }
    PG8_BAR;
    if constexpr (Epi::AFTER_DRAIN) { E.fused(acc, cur, wr, wc, fr, fq, lds, wid, lane); S.done(cur); }
#undef PG8_SA
#undef PG8_SB
#undef PG8_STAGE
#undef PG8_LDA
#undef PG8_LDB
#undef PG8_MMA
#undef PG8_WAIT_V
#undef PG8_WAIT_L
#undef PG8_BAR
#undef PG8_SCHED
}
}
namespace att {
using bf16 = unsigned short;
constexpr int   D = 128, NW = 8, QBLK = 32, KVBLK = 64;
constexpr float SCALE = 0.088388347648318440f;
#ifndef ATT_THR
#define ATT_THR 8.f
#endif
constexpr float THR = ATT_THR;
#ifndef ATT_SDEPTH
#define ATT_SDEPTH 1
#endif
constexpr int SDEPTH = ATT_SDEPTH;
constexpr size_t SHM_V = KVBLK * D * 2, SHM_K = KVBLK * D * 2, SHM_ATTN = 2 * SHM_V + 2 * SHM_K + NW * 64 * 4;
using bf16x8 = __attribute__((ext_vector_type(8))) short;
using s16x4  = __attribute__((ext_vector_type(4))) short;
using f32x16 = __attribute__((ext_vector_type(16))) float;
using f32x8  = __attribute__((ext_vector_type(8))) float;
using u32x4  = __attribute__((ext_vector_type(4))) unsigned;
#define KSWZ(row, colB) ((row) * 256 + ((colB) ^ (((row) & 7) << 4)))
#define SBAR() __builtin_amdgcn_sched_barrier(0)
__device__ __forceinline__ int crow(int r, int hi) { return (r & 3) + 8 * (r >> 2) + 4 * hi; }
__device__ __forceinline__ unsigned cvtpk(float lo, float hi) {
  unsigned r; asm volatile("v_cvt_pk_bf16_f32 %0, %1, %2" : "=v"(r) : "v"(lo), "v"(hi)); return r;
}
template <typename TIn> struct Stage;
template <> struct Stage<bf16>  { using T = bf16x8;
  __device__ static __forceinline__ T ld8(const bf16* p) { return *reinterpret_cast<const bf16x8*>(p); }
  __device__ static __forceinline__ bf16x8 tobf(T x) { return x; } };
template <> struct Stage<float> { using T = f32x8;
  __device__ static __forceinline__ T ld8(const float* p) { return *reinterpret_cast<const f32x8*>(p); }
  __device__ static __forceinline__ bf16x8 tobf(T x) {
    u32x4 w = {cvtpk(x[0], x[1]), cvtpk(x[2], x[3]), cvtpk(x[4], x[5]), cvtpk(x[6], x[7])}; return *reinterpret_cast<bf16x8*>(&w); } };

__device__ __forceinline__ void partialSM(f32x16& p0, f32x16& p1, float& m_reg, float& mn, float& alpha) {
  constexpr float C = SCALE * 1.4426950408889634f;
  float pmax = p0[0]; for (int r = 1; r < 16; ++r) pmax = fmaxf(pmax, p0[r]); for (int r = 0; r < 16; ++r) pmax = fmaxf(pmax, p1[r]);
  { auto rr = __builtin_amdgcn_permlane32_swap(__float_as_uint(pmax), __float_as_uint(pmax), false, false);
    pmax = fmaxf(__uint_as_float(rr[0]), __uint_as_float(rr[1])); }
  if (__builtin_expect(__all(pmax - m_reg <= THR / SCALE), 1)) { mn = m_reg; alpha = 1.f; }
  else { mn = fmaxf(m_reg, pmax); alpha = __builtin_amdgcn_exp2f((m_reg - mn) * C); m_reg = mn; }
  float mnC = -mn * C;
  for (int r = 0; r < 16; ++r) p0[r] = fmaf(p0[r], C, mnC); for (int r = 0; r < 16; ++r) p1[r] = fmaf(p1[r], C, mnC);
  for (int r = 0; r < 16; ++r) p0[r] = __builtin_amdgcn_exp2f(p0[r]);
}
__device__ __forceinline__ void finishSM(f32x16& p0, f32x16& p1, float alpha, float& l_reg, bf16x8& pa0, bf16x8& pa1, bf16x8& pa2, bf16x8& pa3) {
  for (int r = 0; r < 16; ++r) p1[r] = __builtin_amdgcn_exp2f(p1[r]);
  float ps = 0; for (int r = 0; r < 16; ++r) ps += p0[r]; for (int r = 0; r < 16; ++r) ps += p1[r];
  { auto rr = __builtin_amdgcn_permlane32_swap(__float_as_uint(ps), __float_as_uint(ps), false, false);
    ps = __uint_as_float(rr[0]) + __uint_as_float(rr[1]); }
  l_reg = l_reg * alpha + ps;
#define PK4(P, BASE, OUT) do { unsigned a0 = cvtpk(P[BASE + 0], P[BASE + 1]), a1 = cvtpk(P[BASE + 2], P[BASE + 3]);   \
    unsigned b0 = cvtpk(P[BASE + 4], P[BASE + 5]), b1 = cvtpk(P[BASE + 6], P[BASE + 7]);                              \
    auto r0 = __builtin_amdgcn_permlane32_swap(a0, b0, false, false); auto r1 = __builtin_amdgcn_permlane32_swap(a1, b1, false, false); \
    u32x4 w = {r0[0], r1[0], r0[1], r1[1]}; OUT = *reinterpret_cast<bf16x8*>(&w); } while (0)
  PK4(p0, 0, pa0); PK4(p0, 8, pa1); PK4(p1, 0, pa2); PK4(p1, 8, pa3);
#undef PK4
}
__device__ __forceinline__ void qkt(f32x16& p0, f32x16& p1, const bf16* Ks, const bf16x8* qr, int r32, int hi) {
  p0 = f32x16{}; p1 = f32x16{};
  for (int d0 = 0; d0 < 8; ++d0) { int cb = (d0 * 16 + hi * 8) * 2;
    bf16x8 b0 = *reinterpret_cast<const bf16x8*>((const char*)Ks + KSWZ(r32, cb));
    bf16x8 b1 = *reinterpret_cast<const bf16x8*>((const char*)Ks + KSWZ(32 + r32, cb));
    p0 = __builtin_amdgcn_mfma_f32_32x32x16_bf16(b0, qr[d0], p0, 0, 0, 0);
    p1 = __builtin_amdgcn_mfma_f32_32x32x16_bf16(b1, qr[d0], p1, 0, 0, 0); }
}
__device__ __forceinline__ int v_st(int k, int c) { const int kk = (k & ~0xC) | ((k & 4) << 1) | ((k & 8) >> 1); return ((kk >> 3) * 4 + (c >> 5)) * 512 + ((kk & 7) * 32 + (c & 31)) * 2; }
__device__ __forceinline__ int v_rd_base(int lane) { return ((lane & 3) << 3) | (((lane >> 2) & 3) << 6) | (((lane >> 4) & 1) << 5) | (((lane >> 5) & 1) << 8); }
constexpr int v_rd_off(int d0, int ks, int half) { return d0 * 512 + ks * 4096 + half * 2048; }
template <int OFF> __device__ __forceinline__ s16x4 tr_read(int vb) {
  s16x4 r; asm volatile("ds_read_b64_tr_b16 %0, %1 offset:%2" : "=&v"(r) : "v"(vb), "i"(OFF) : "memory"); return r;
}
template <int D0> __device__ __forceinline__ void pv_one(f32x16& od, int vb, bf16x8 pa0, bf16x8 pa1, bf16x8 pa2, bf16x8 pa3) {
  const s16x4 l0 = tr_read<v_rd_off(D0, 0, 0)>(vb), h0 = tr_read<v_rd_off(D0, 0, 1)>(vb), l1 = tr_read<v_rd_off(D0, 1, 0)>(vb), h1 = tr_read<v_rd_off(D0, 1, 1)>(vb);
  const s16x4 l2 = tr_read<v_rd_off(D0, 2, 0)>(vb), h2 = tr_read<v_rd_off(D0, 2, 1)>(vb), l3 = tr_read<v_rd_off(D0, 3, 0)>(vb), h3 = tr_read<v_rd_off(D0, 3, 1)>(vb);
  asm volatile("s_waitcnt lgkmcnt(0)" ::: "memory"); SBAR();
#define PK(L, H) (bf16x8){L[0], L[1], L[2], L[3], H[0], H[1], H[2], H[3]}
  od = __builtin_amdgcn_mfma_f32_32x32x16_bf16(pa0, PK(l0, h0), od, 0, 0, 0);
  od = __builtin_amdgcn_mfma_f32_32x32x16_bf16(pa1, PK(l1, h1), od, 0, 0, 0);
  od = __builtin_amdgcn_mfma_f32_32x32x16_bf16(pa2, PK(l2, h2), od, 0, 0, 0);
  od = __builtin_amdgcn_mfma_f32_32x32x16_bf16(pa3, PK(l3, h3), od, 0, 0, 0);
#undef PK
}
__device__ __forceinline__ void pv_d0(f32x16* o, int vb, bf16x8 pa0, bf16x8 pa1, bf16x8 pa2, bf16x8 pa3) {
  pv_one<0>(o[0], vb, pa0, pa1, pa2, pa3); pv_one<1>(o[1], vb, pa0, pa1, pa2, pa3); pv_one<2>(o[2], vb, pa0, pa1, pa2, pa3); pv_one<3>(o[3], vb, pa0, pa1, pa2, pa3);
}
struct DenseTiles { int base;
  __device__ __forceinline__ int krow(int j) const { return base + j * KVBLK; }
  __device__ __forceinline__ void mask(f32x16&, f32x16&, int, int, int, int) const {} };
__device__ __forceinline__ void partialSM_fix(f32x16& p0, f32x16& p1, float mfixC) {
#pragma unroll
  for (int r = 0; r < 16; ++r) p0[r] = __builtin_amdgcn_exp2f(p0[r]);
}
template <int ld, class TF, bool FIX>
__device__ __forceinline__ void attn_body(const bf16* __restrict__ Qb, const bf16* __restrict__ Kh, const bf16* __restrict__ Vh, const bf16* __restrict__ Gb,
                                          bf16* __restrict__ Ob, int NT, const TF& T, char* lds, float mfixC) {
  using St = Stage<bf16>;
  const int tid = ltid(), wid = tid >> 6, lane = tid & 63, r32 = lane & 31, hi = lane >> 5;
  bf16* V_lds = (bf16*)lds; bf16* K_lds = (bf16*)(lds + 2 * SHM_V);
  float* ws = (float*)(lds + 2 * SHM_V + 2 * SHM_K) + wid * 64; float* li_l = ws; float* al_l = ws + 32;
  float m_reg = -1e30f, l_reg = 0; f32x16 o[4] = {}; bf16x8 qr[8];
  const bf16* Qw = Qb + (long)(wid * QBLK + r32) * ld + hi * 8;
#pragma unroll
  for (int d0 = 0; d0 < 8; ++d0) qr[d0] = St::ld8(Qw + d0 * 16);
  const int sr = tid >> 4, sc = (tid & 15) * 8, vst0 = v_st(sr, sc), vst1 = v_st(32 + sr, sc);
  const int vb0 = (int)(uintptr_t)V_lds + v_rd_base(lane);
  struct { typename St::T vs0, vs1, ks0, ks1; } sr_[SDEPTH];
#define SLOAD(i, k0) do { const long _k0 = (k0); sr_[i].vs0 = St::ld8(&Vh[(_k0 + sr) * ld + sc]); sr_[i].vs1 = St::ld8(&Vh[(_k0 + 32 + sr) * ld + sc]); \
    sr_[i].ks0 = St::ld8(&Kh[(_k0 + sr) * ld + sc]); sr_[i].ks1 = St::ld8(&Kh[(_k0 + 32 + sr) * ld + sc]); } while (0)
#define SWRITE(b, i) do { *(bf16x8*)((char*)V_lds + (b) * SHM_V + vst0) = St::tobf(sr_[i].vs0);          \
    *(bf16x8*)((char*)V_lds + (b) * SHM_V + vst1) = St::tobf(sr_[i].vs1); int kc = sc * 2;               \
    *(bf16x8*)((char*)K_lds + (b) * SHM_K + KSWZ(sr, kc)) = St::tobf(sr_[i].ks0);                       \
    *(bf16x8*)((char*)K_lds + (b) * SHM_K + KSWZ(32 + sr, kc)) = St::tobf(sr_[i].ks1); } while (0)
#define SWAIT() do { if constexpr (SDEPTH == 2) asm volatile("s_waitcnt vmcnt(4)" ::: "memory"); else asm volatile("s_waitcnt vmcnt(0)" ::: "memory"); } while (0)
#define RESC(a) do { if (__any((a) < 1.f)) { if (hi == 0) al_l[r32] = (a); asm volatile("s_waitcnt lgkmcnt(0)" ::: "memory"); \
    for (int d = 0; d < 4; ++d) for (int r = 0; r < 16; ++r) o[d][r] *= al_l[crow(r, hi)]; } } while (0)
  f32x16 pA0, pA1, pB0, pB1; float mnA, mnB, alA, alB; bf16x8 pa0, pa1, pa2, pa3;
  constexpr int SE = 0, SO = SDEPTH - 1;
  SLOAD(SE, T.krow(0)); asm volatile("s_waitcnt vmcnt(0)" ::: "memory"); SWRITE(0, SE); __syncthreads();
  qkt(pA0, pA1, K_lds, qr, r32, hi); T.mask(pA0, pA1, 0, wid, r32, hi); if constexpr (FIX) { partialSM_fix(pA0, pA1, mfixC); alA = 1.f; } else partialSM(pA0, pA1, m_reg, mnA, alA);
  SLOAD(SO, T.krow(1)); if constexpr (SDEPTH == 2) { if (2 < NT) SLOAD(SE, T.krow(2)); }
  SWAIT(); SWRITE(1, SO); __syncthreads();
  for (int j = 1; j + 1 < NT; j += 2) {
    SBAR(); qkt(pB0, pB1, (bf16*)((char*)K_lds + SHM_K), qr, r32, hi); T.mask(pB0, pB1, j, wid, r32, hi);
    finishSM(pA0, pA1, alA, l_reg, pa0, pa1, pa2, pa3); SBAR();
    SLOAD(SO, T.krow(j + SDEPTH)); SBAR();
    pv_d0(o, vb0, pa0, pa1, pa2, pa3); if constexpr (FIX) { partialSM_fix(pB0, pB1, mfixC); alB = 1.f; } else partialSM(pB0, pB1, m_reg, mnB, alB);
    __syncthreads(); SWAIT(); SWRITE(0, SE);
    if constexpr (!FIX) RESC(alB); __syncthreads();
    SBAR(); qkt(pA0, pA1, K_lds, qr, r32, hi); T.mask(pA0, pA1, j + 1, wid, r32, hi);
    finishSM(pB0, pB1, alB, l_reg, pa0, pa1, pa2, pa3); SBAR();
    if (SDEPTH == 1 || j + 3 < NT) SLOAD(SE, T.krow(j + 1 + SDEPTH)); SBAR();
    pv_d0(o, vb0 + (int)SHM_V, pa0, pa1, pa2, pa3); if constexpr (FIX) { partialSM_fix(pA0, pA1, mfixC); alA = 1.f; } else partialSM(pA0, pA1, m_reg, mnA, alA);
    __syncthreads(); SWAIT(); SWRITE(1, SO);
    if constexpr (!FIX) RESC(alA); __syncthreads();
  }
  SBAR(); qkt(pB0, pB1, (bf16*)((char*)K_lds + SHM_K), qr, r32, hi); T.mask(pB0, pB1, NT - 1, wid, r32, hi);
  finishSM(pA0, pA1, alA, l_reg, pa0, pa1, pa2, pa3); SBAR();
  pv_d0(o, vb0, pa0, pa1, pa2, pa3); if constexpr (FIX) { partialSM_fix(pB0, pB1, mfixC); alB = 1.f; } else partialSM(pB0, pB1, m_reg, mnB, alB);
  __syncthreads(); if constexpr (!FIX) RESC(alB);
  finishSM(pB0, pB1, alB, l_reg, pa0, pa1, pa2, pa3); SBAR();
  pv_d0(o, vb0 + (int)SHM_V, pa0, pa1, pa2, pa3);
  if (hi == 0) li_l[r32] = l_reg; asm volatile("s_waitcnt lgkmcnt(0)" ::: "memory");
  float rli[16];
#pragma unroll
  for (int r = 0; r < 16; ++r) rli[r] = __builtin_amdgcn_rcpf(li_l[crow(r, hi)]);
  __syncthreads();
  bf16* ot = (bf16*)lds + wid * (32 * 136);
#pragma unroll
  for (int r = 0; r < 16; ++r) { const int orow = crow(r, hi);
#pragma unroll
    for (int d0 = 0; d0 < 4; ++d0) ot[orow * 136 + d0 * 32 + r32] = ::f2bf(o[d0][r] * rli[r]); }
  asm volatile("s_waitcnt lgkmcnt(0)" ::: "memory");
  bf16* Ow = (bf16*)((unsigned char*)Ob + (long)(wid * QBLK) * 2048); const bf16* Gw = Gb + (long)(wid * QBLK) * ld;
#pragma unroll 2
  for (int c = 0; c < 8; ++c) { const int idx = c * 64 + lane, row = idx >> 4, ch = (idx & 15) * 8;
    const u32x4 ov = *(const u32x4*)(ot + row * 136 + ch); const u32x4 gv = *(const u32x4*)(Gw + (long)row * ld + ch); float f[8];
#pragma unroll
    for (int e = 0; e < 4; ++e) { const float g0 = ::bf_lo(gv[e]), g1 = ::bf_hi(gv[e]); f[2 * e] = ::bf_lo(ov[e]) * ::siluf_(g0) * OG_SCALE; f[2 * e + 1] = ::bf_hi(ov[e]) * ::siluf_(g1) * OG_SCALE; }
    u32x2 w; w.x = ::pack4_fp8_sat((f32x4){f[0], f[1], f[2], f[3]}); w.y = ::pack4_fp8_sat((f32x4){f[4], f[5], f[6], f[7]});
    *(u32x2*)((unsigned char*)Ow + (long)row * 2048 + ch) = w; }
  __syncthreads();
#undef SLOAD
#undef SWRITE
#undef SWAIT
#undef RESC
}

__device__ __forceinline__ void na_wave(const bf16* __restrict__ PB, bf16* __restrict__ OG, const float* rpb, int qrow, int c0, int h, char* wlds, int lane) {
  constexpr int ld = LDE;
  const int r32 = lane & 31, hi = lane >> 5;
  const bf16* Qw = PB + (size_t)(qrow * 64 + c0 + r32) * ld + h * 128 + hi * 8;
  bf16x8 qr[8];
#pragma unroll
  for (int d0 = 0; d0 < 8; ++d0) qr[d0] = *(const bf16x8*)(Qw + d0 * 16);
  float m_reg = -1e30f, l_reg = 0.f; f32x16 o[4] = {};
  float* al_l = (float*)(wlds + 16384);
  int rs = qrow - 4; rs = rs < 0 ? 0 : (rs > 120 ? 120 : rs);
  const int qc = c0 + r32; int cs = qc - 8; cs = cs < 0 ? 0 : (cs > 48 ? 48 : cs);
  const int vb0 = (int)(uintptr_t)wlds + v_rd_base(lane);
  const int skey = lane >> 4, scol = (lane & 15) * 8;
  for (int j = 0; j < 12; ++j) {
    const int krow = j < 4 ? SEQ + 64 * j : (rs + j - 4) * 64;
    const bf16* Kt = PB + (size_t)krow * ld + 1024 + h * 128; const bf16* Vt = Kt + 1024;
#pragma unroll
    for (int hf = 0; hf < 2; ++hf) { bf16x8 v[8];
#pragma unroll
      for (int it = 0; it < 8; ++it) v[it] = *(const bf16x8*)(Vt + (size_t)((hf * 8 + it) * 4 + skey) * ld + scol);
#pragma unroll
      for (int it = 0; it < 8; ++it) *(bf16x8*)(wlds + v_st((hf * 8 + it) * 4 + skey, scol)) = v[it]; }
    f32x16 p0 = {}, p1 = {};
#pragma unroll
    for (int d0 = 0; d0 < 8; ++d0) { const bf16x8 b0 = *(const bf16x8*)(Kt + (size_t)r32 * ld + d0 * 16 + hi * 8), b1 = *(const bf16x8*)(Kt + (size_t)(32 + r32) * ld + d0 * 16 + hi * 8);
      p0 = __builtin_amdgcn_mfma_f32_32x32x16_bf16(b0, qr[d0], p0, 0, 0, 0); p1 = __builtin_amdgcn_mfma_f32_32x32x16_bf16(b1, qr[d0], p1, 0, 0, 0); }
    if (j >= 4) { const int bi = (rs + j - 4 - qrow + 7) * 31 - qc + 15;
#pragma unroll
      for (int r = 0; r < 16; ++r) { const int kc = crow(r, hi);
        { const bool ok = (kc >= cs) && (kc < cs + 16); const float b = rpb[ok ? bi + kc : 0]; p0[r] = ok ? p0[r] + b : -1e30f; }
        { const int k1 = kc + 32; const bool ok = (k1 >= cs) && (k1 < cs + 16); const float b = rpb[ok ? bi + k1 : 0]; p1[r] = ok ? p1[r] + b : -1e30f; } } }
#ifdef EXP_NA_UNIFORM
#pragma unroll
    for (int r = 0; r < 16; ++r) { if (p0[r] > -1e29f) p0[r] = 0.f; if (p1[r] > -1e29f) p1[r] = 0.f; }
#endif
    float mn, alpha; bf16x8 pa0, pa1, pa2, pa3;
    partialSM(p0, p1, m_reg, mn, alpha);
    finishSM(p0, p1, alpha, l_reg, pa0, pa1, pa2, pa3);
    if (__any(alpha < 1.f)) { if (hi == 0) al_l[r32] = alpha; asm volatile("s_waitcnt lgkmcnt(0)" ::: "memory");
#pragma unroll
      for (int d = 0; d < 4; ++d)
#pragma unroll
        for (int r = 0; r < 16; ++r) o[d][r] *= al_l[crow(r, hi)]; }
    pv_d0(o, vb0, pa0, pa1, pa2, pa3);
  }
  if (hi == 0) al_l[r32] = l_reg; asm volatile("s_waitcnt lgkmcnt(0)" ::: "memory");
  float rli[16];
#pragma unroll
  for (int r = 0; r < 16; ++r) rli[r] = __builtin_amdgcn_rcpf(al_l[crow(r, hi)]);
  bf16* ot = (bf16*)wlds;
#pragma unroll
  for (int r = 0; r < 16; ++r) { const int orow = crow(r, hi);
#pragma unroll
    for (int d0 = 0; d0 < 4; ++d0) ot[orow * 136 + d0 * 32 + r32] = ::f2bf(o[d0][r] * rli[r]); }
  asm volatile("s_waitcnt lgkmcnt(0)" ::: "memory");
  const size_t t0 = (size_t)(qrow * 64 + c0);
#pragma unroll 2
  for (int c = 0; c < 8; ++c) { const int idx = c * 64 + lane, row = idx >> 4, ch = (idx & 15) * 8;
    const u32x4 ov = *(const u32x4*)(ot + row * 136 + ch); const u32x4 gv = *(const u32x4*)(PB + (t0 + row) * ld + 3072 + h * 128 + ch); float f[8];
#pragma unroll
    for (int e = 0; e < 4; ++e) { const float g0 = ::bf_lo(gv[e]), g1 = ::bf_hi(gv[e]); f[2 * e] = ::bf_lo(ov[e]) * ::siluf_(g0) * OG_SCALE; f[2 * e + 1] = ::bf_hi(ov[e]) * ::siluf_(g1) * OG_SCALE; }
    u32x2 w; w.x = ::pack4_fp8_sat((f32x4){f[0], f[1], f[2], f[3]}); w.y = ::pack4_fp8_sat((f32x4){f[4], f[5], f[6], f[7]});
    *(u32x2*)((unsigned char*)OG + (t0 + row) * 2048 + h * 128 + ch) = w; }
  asm volatile("s_waitcnt lgkmcnt(0)" ::: "memory");
}
}

constexpr size_t MiB = 1u << 20;
constexpr size_t WS_WEVIN = 1 * MiB, WS_WEVOUT = 49 * MiB, WS_WGLU = 65 * MiB, WS_WODIN = 69 * MiB, WS_WODOUT = 109 * MiB;
constexpr size_t WS_T1 = 125 * MiB, WS_T2 = 141 * MiB, WS_LAM = 173 * MiB;
constexpr size_t WS_MODP = 430 * MiB, WS_MOD = 178 * MiB;
constexpr size_t WS_X = 179 * MiB, WS_H = 245 * MiB, WS_P = 278 * MiB, WS_OG = 380 * MiB, WS_ZB = 413 * MiB, WS_S = 430 * MiB, WS_HB = 463 * MiB, WS_END = 480 * MiB;
constexpr int LDS_BYTES = 131072 + 8192;
constexpr int NPH = 27;

struct Params {
    const float *x, *c, *ctx, *c_ctx, *ada_w, *ada_b, *ln_g, *ln_b, *ev_w_in, *ev_w_out, *na_rpb, *s5_a_re, *s5_a_im, *s5_log_dt, *s5_b_re, *s5_b_im, *s5_c_re, *s5_c_im, *s5_d,
        *s5_glu_w, *s5_glu_b, *od_w_in, *od_w_out, *q_norm_g, *k_norm_g;
    float* out; unsigned char* ws; int ph_lo, ph_hi;
};

struct TrItem { const float* W; bf16_t* WT; int K, N, item; float sc; bool fp8; };
__device__ __forceinline__ void tr_load(const TrItem& m, int lane, f32x4 (&v)[16]) {
    const int nblk = m.N / 64, kb = m.item / nblk, nb = m.item % nblk, k0 = 64 * kb, n0 = 64 * nb;
#pragma unroll
    for (int i = 0; i < 16; ++i) v[i] = __builtin_nontemporal_load((const f32x4*)(m.W + (size_t)(k0 + 4 * i + (lane >> 4)) * m.N + n0 + (lane & 15) * 4));
}
__device__ __forceinline__ void tr_store(const TrItem& m, int lane, const f32x4 (&v)[16], LAS float* scr) {
    const int nblk = m.N / 64, kb = m.item / nblk, nb = m.item % nblk, k0 = 64 * kb, n0 = 64 * nb, K = m.K;
#pragma unroll
    for (int i = 0; i < 16; ++i) { LAS float* d = scr + (4 * i + (lane >> 4)) * 65 + (lane & 15) * 4; d[0] = v[i][0]; d[1] = v[i][1]; d[2] = v[i][2]; d[3] = v[i][3]; }
    asm volatile("s_waitcnt lgkmcnt(0)" ::: "memory");
    const int c = lane & 7;
#pragma unroll
    for (int j = 0; j < 8; ++j) { const int n = (lane >> 3) + 8 * j; const LAS float* s = scr + (8 * c) * 65 + n;
        if (m.fp8) { u32x2 o; o.x = pack4_fp8((f32x4){s[0 * 65], s[1 * 65], s[2 * 65], s[3 * 65]} * m.sc); o.y = pack4_fp8((f32x4){s[4 * 65], s[5 * 65], s[6 * 65], s[7 * 65]} * m.sc);
            *(u32x2*)((unsigned char*)m.WT + (size_t)(n0 + n) * K + k0 + 8 * c) = o; }
        else { u32x4 o; o.x = cvt_pk_bf16(s[0 * 65], s[1 * 65]); o.y = cvt_pk_bf16(s[2 * 65], s[3 * 65]); o.z = cvt_pk_bf16(s[4 * 65], s[5 * 65]); o.w = cvt_pk_bf16(s[6 * 65], s[7 * 65]);
            *(u32x4*)(m.WT + (size_t)(n0 + n) * K + k0 + 8 * c) = o; } }
    asm volatile("s_waitcnt lgkmcnt(0)" ::: "memory");
}

__device__ __forceinline__ void s5_tables_item(const Params& P, int i, int g, LAS float* L) {
    LAS float* pw = L;
    LAS float* BbRe = L + 4352;
    LAS float* BbIm = BbRe + 2048;
    LAS float* CRe = BbIm + 2048;
    LAS float* CIm = CRe + 2048;
    LAS float* Kt = CIm + 2048;
    const int tid = ltid();
    bf16_t* T1 = (bf16_t*)(lws(P.ws) + WS_T1) + (size_t)(i * 64 + g) * 256 * 256;
    bf16_t* T2 = (bf16_t*)(lws(P.ws) + WS_T2) + (size_t)(i * 64 + g) * 256 * 512;
    float* LAM = (float*)(lws(P.ws) + WS_LAM) + (size_t)(i * 64 + g) * 256;
    __syncthreads();
    if (tid < 128) {
        const int dir = tid >> 6, pp = tid & 63, idx = (i * 2 + dir) * 64 + g;
        const float dt = __expf(P.s5_log_dt[idx]), are = P.s5_a_re[idx * 64 + pp], aim = P.s5_a_im[idx * 64 + pp];
        const float mag = __expf(are * dt); float rev = aim * dt * 0.15915494309189535f; rev -= floorf(rev);
        const float lre = mag * __builtin_amdgcn_cosf(rev), lim = mag * __builtin_amdgcn_sinf(rev);
        const float den = are * are + aim * aim, nre = lre - 1.f, nim = lim;
        const float fre = (nre * are + nim * aim) / den, fim = (nim * are - nre * aim) / den;
        float cr = 1.f, ci = 0.f;
        for (int d = 0; d <= 16; ++d) { pw[((dir * 17 + d) * 64 + pp) * 2] = cr; pw[((dir * 17 + d) * 64 + pp) * 2 + 1] = ci; const float nr = cr * lre - ci * lim, ni = cr * lim + ci * lre; cr = nr; ci = ni; }
        LAM[(dir * 64 + pp) * 2] = pw[((dir * 17 + 16) * 64 + pp) * 2]; LAM[(dir * 64 + pp) * 2 + 1] = pw[((dir * 17 + 16) * 64 + pp) * 2 + 1];
        for (int c = 0; c < 16; ++c) { const float bre = P.s5_b_re[(size_t)(idx * 64 + pp) * 16 + c], bim = P.s5_b_im[(size_t)(idx * 64 + pp) * 16 + c];
            BbRe[(dir * 64 + pp) * 16 + c] = fre * bre - fim * bim; BbIm[(dir * 64 + pp) * 16 + c] = fre * bim + fim * bre; }
    }
    for (int e = tid; e < 2048; e += 512) { const int dir = e >> 10, r = e & 1023; const size_t src = (size_t)((i * 2 + dir) * 64 + g) * 1024 + r; CRe[e] = P.s5_c_re[src]; CIm[e] = P.s5_c_im[src]; }
    __syncthreads();
    {   const int dir = tid >> 8, d = (tid >> 4) & 15, co = tid & 15; float acc[16];
#pragma unroll
        for (int c = 0; c < 16; ++c) acc[c] = 0.f;
        for (int pp = 0; pp < 64; ++pp) { const float cr = CRe[(dir * 16 + co) * 64 + pp], ci = CIm[(dir * 16 + co) * 64 + pp], wr_ = pw[((dir * 17 + d) * 64 + pp) * 2], wi = pw[((dir * 17 + d) * 64 + pp) * 2 + 1];
            const float gre = cr * wr_ - ci * wi, gim = cr * wi + ci * wr_;
#pragma unroll
            for (int c = 0; c < 16; ++c) acc[c] += gre * BbRe[(dir * 64 + pp) * 16 + c] - gim * BbIm[(dir * 64 + pp) * 16 + c]; }
#pragma unroll
        for (int c = 0; c < 16; ++c) Kt[((dir * 16 + d) * 16 + co) * 16 + c] = acc[c];
    }
    __syncthreads();
    for (int ch = tid; ch < 16384; ch += 512) {
        const int f = ch >> 6, cc = ch & 63, t = f >> 4, co = f & 15; float v[8];
        if (cc < 32) { const int s = cc >> 1, ci0 = (cc & 1) * 8;
#pragma unroll
            for (int e = 0; e < 8; ++e) { const int ci = ci0 + e; float a = 0.f;
#ifndef EXP_NO_SCAN
                if (t >= s) a += Kt[((0 * 16 + (t - s)) * 16 + co) * 16 + ci];
                if (s >= t) a += Kt[((1 * 16 + (s - t)) * 16 + co) * 16 + ci];
#endif
                if (s == t && co == ci) a += P.s5_d[i * 1024 + g * 16 + co];
                v[e] = a; }
        } else { const int q = (cc - 32) >> 3, p0 = ((cc - 32) & 7) * 8, dir = q >> 1, im = q & 1, pwr = dir == 0 ? t + 1 : 16 - t;
#pragma unroll
            for (int e = 0; e < 8; ++e) { const int pp = p0 + e; const float cr = CRe[(dir * 16 + co) * 64 + pp], ci = CIm[(dir * 16 + co) * 64 + pp], wr_ = pw[((dir * 17 + pwr) * 64 + pp) * 2], wi = pw[((dir * 17 + pwr) * 64 + pp) * 2 + 1];
                v[e] = im ? -(cr * wi + ci * wr_) : (cr * wr_ - ci * wi);
#if defined(EXP_NO_SCAN) || defined(EXP_NO_CARRY)
                v[e] = 0.f;
#endif
#ifdef EXP_NO_CARRY_B
                if (dir == 1) v[e] = 0.f;
#endif
            } }
        u32x4 w; w.x = cvt_pk_bf16(v[0], v[1]); w.y = cvt_pk_bf16(v[2], v[3]); w.z = cvt_pk_bf16(v[4], v[5]); w.w = cvt_pk_bf16(v[6], v[7]);
        *(u32x4*)(T2 + ((size_t)(((f >> 5) * 32 + (cc >> 1)) * 64 + (cc & 1) * 32 + (f & 31))) * 8) = w;
    }
    for (int ch = tid; ch < 8192; ch += 512) {
        const int row = ch >> 5, cc = ch & 31, s = cc >> 1, ci0 = (cc & 1) * 8, dir = row >> 7, im = (row >> 6) & 1, pp = row & 63, pwr = dir == 0 ? 15 - s : s; float v[8];
        const float wr_ = pw[((dir * 17 + pwr) * 64 + pp) * 2], wi = pw[((dir * 17 + pwr) * 64 + pp) * 2 + 1];
#pragma unroll
        for (int e = 0; e < 8; ++e) { const float br = BbRe[(dir * 64 + pp) * 16 + ci0 + e], bi = BbIm[(dir * 64 + pp) * 16 + ci0 + e]; v[e] = im ? (wr_ * bi + wi * br) : (wr_ * br - wi * bi); }
        u32x4 w; w.x = cvt_pk_bf16(v[0], v[1]); w.y = cvt_pk_bf16(v[2], v[3]); w.z = cvt_pk_bf16(v[4], v[5]); w.w = cvt_pk_bf16(v[6], v[7]);
        *(u32x4*)(T1 + ((size_t)(((row >> 5) * 16 + (cc >> 1)) * 64 + (cc & 1) * 32 + (row & 31))) * 8) = w;
    }
    __syncthreads();
}

__device__ __forceinline__ TrItem seg_item(const Params& P, unsigned char* ws, int seg, int j) {
    TrItem m; m.K = 2048; m.N = 2048; m.fp8 = true; m.sc = WOUT_SCALE;
    const int i = seg >= 2 ? 1 : 0;
    if (seg == 0 || (seg == 2 && j < 3072)) { m.W = P.ev_w_in + (size_t)i * 2048 * 6144; m.N = 6144; m.sc = WIN_SCALE; m.WT = (bf16_t*)(ws + WS_WEVIN + (size_t)i * 6144 * 2048); }
    else if (seg == 1 || seg == 2) {
        if (seg == 2) j -= 3072;
        if (j < 1024) { m.W = P.ev_w_out + (size_t)i * 2048 * 2048; m.WT = (bf16_t*)(ws + WS_WEVOUT + (size_t)i * 2048 * 2048); }
        else if ((j -= 1024) < 256) { m.W = P.s5_glu_w + (size_t)i * 1024 * 1024; m.K = 1024; m.N = 1024; m.fp8 = false; m.sc = 1.f; m.WT = (bf16_t*)(ws + WS_WGLU) + (size_t)i * 1024 * 1024; }
        else if ((j -= 256) < 2560) { m.W = P.od_w_in + (size_t)i * 2048 * 5120; m.N = 5120; m.sc = WIN_SCALE; m.WT = (bf16_t*)(ws + WS_WODIN + (size_t)i * 5120 * 2048); }
        else { j -= 2560; m.W = P.od_w_out + (size_t)i * 2048 * 2048; m.WT = (bf16_t*)(ws + WS_WODOUT + (size_t)i * 2048 * 2048); }
    } else if (seg == 3) { m.W = P.od_w_in + (size_t)i * 2048 * 5120; m.N = 5120; m.sc = WIN_SCALE; m.WT = (bf16_t*)(ws + WS_WODIN + (size_t)i * 5120 * 2048); }
    else { m.W = P.od_w_out + (size_t)i * 2048 * 2048; m.WT = (bf16_t*)(ws + WS_WODOUT + (size_t)i * 2048 * 2048); }
    m.item = j; return m;
}
__device__ __forceinline__ void convert_seg(const Params& P, int seg, int vw, int nvw, LAS float* scr, int lane) {
    unsigned char* ws = lws(P.ws);
    const int nitems = seg == 0 ? 3072 : seg == 1 ? 4864 : seg == 2 ? 4352 : seg == 3 ? 2560 : 1024;
    f32x4 va[16], vb[16]; TrItem m0, m1; int j = vw;
    if (j < nitems) { m0 = seg_item(P, ws, seg, j); tr_load(m0, lane, va); }
    while (j < nitems) {
        const int j1 = j + nvw, j2 = j1 + nvw;
        if (j1 < nitems) { m1 = seg_item(P, ws, seg, j1); tr_load(m1, lane, vb); }
        tr_store(m0, lane, va, scr);
        if (j2 < nitems) { m0 = seg_item(P, ws, seg, j2); tr_load(m0, lane, va); }
        if (j1 < nitems) tr_store(m1, lane, vb, scr);
        j = j2;
    }
}
__device__ __forceinline__ void phase_prologue(const Params& P, LAS unsigned char* lds) {
    const int tid = ltid(), lane = tid & 63, wid = tid >> 6, G = gridDim.x;
    unsigned char* ws = lws(P.ws);
    if (lbid() < 128) s5_tables_item(P, lbid() >> 6, lbid() & 63, (LAS float*)lds);
    __syncthreads();
    {
        LAS float* sv = (LAS float*)lds;
        for (int e = tid; e < 2048; e += 512) { sv[e] = siluf_(P.c[e]); sv[2048 + e] = siluf_(P.c_ctx[e]); }
        __syncthreads();
        float* MODP = (float*)(ws + WS_MODP);
        for (int it = lbid(); it < 768; it += G) {
            const int l = it / 192, rem = it % 192, cb = rem >> 6, ks = rem & 63, col = cb * 2048 + tid * 4;
            const float* w = P.ada_w + ((size_t)l * 2048 + ks * 32) * 6144 + col; f32x4 a0 = {0.f, 0.f, 0.f, 0.f}, a1 = {0.f, 0.f, 0.f, 0.f};
#pragma unroll 16
            for (int k = 0; k < 32; ++k) { const f32x4 wv = __builtin_nontemporal_load((const f32x4*)(w + (size_t)k * 6144)); a0 += wv * sv[ks * 32 + k]; a1 += wv * sv[2048 + ks * 32 + k]; }
            *(f32x4*)(MODP + ((size_t)(l * 64 + ks) * 2 + 0) * 6144 + col) = a0; *(f32x4*)(MODP + ((size_t)(l * 64 + ks) * 2 + 1) * 6144 + col) = a1;
        }
    }
    __syncthreads();
    if (lbid() >= 128) convert_seg(P, 0, (lbid() - 128) * 8 + wid, (G - 128) * 8, (LAS float*)(lds + wid * 16640), lane);
}

__device__ __forceinline__ void phase_finalize_mod(const Params& P) {
    const float* MODP = (const float*)(lws(P.ws) + WS_MODP); float* MOD = (float*)(lws(P.ws) + WS_MOD);
    for (int e = lbid() * 512 + ltid(); e < 4 * 2 * 6144; e += gridDim.x * 512) {
        const int l = e / 12288, v = (e / 6144) & 1, col = e % 6144; float s = P.ada_b[l * 6144 + col];
        for (int ks = 0; ks < 64; ++ks) s += MODP[((size_t)(l * 64 + ks) * 2 + v) * 6144 + col];
        MOD[e] = s;
    }
}
__device__ __forceinline__ void mod_row(const f32x4 (&v)[8], const float* sh, const float* sc, bf16_t* hrow, int lane) {
#pragma unroll
    for (int j = 0; j < 8; ++j) { const int col = 4 * lane + 256 * j; const f32x4 s = *(const f32x4*)(sc + col), t = *(const f32x4*)(sh + col); const f32x4 h = v[j] * (s + 1.f) + t;
        *(unsigned*)((unsigned char*)hrow + col) = pack4_fp8(h); }
}
__device__ __forceinline__ void phase_mod0(const Params& P) {
    const int lane = ltid() & 63, gw = lbid() * 8 + (ltid() >> 6), NGW = gridDim.x * 8;
    const float* MOD = (const float*)(lws(P.ws) + WS_MOD); unsigned char* H = lws(P.ws) + WS_H;
    {
        f32x4 s1[8], t[8];
#pragma unroll
        for (int j = 0; j < 8; ++j) { const int col = 4 * lane + 256 * j; s1[j] = *(const f32x4*)(MOD + 1 * 2048 + col) + 1.f; t[j] = *(const f32x4*)(MOD + col); }
        for (int r = gw; r < SEQ; r += 4 * NGW) { f32x4 x[4][8];
#pragma unroll
            for (int k = 0; k < 4; ++k) { const int rk = r + k * NGW; if (rk < SEQ) {
#pragma unroll
                for (int j = 0; j < 8; ++j) x[k][j] = __builtin_nontemporal_load((const f32x4*)(P.x + (size_t)rk * DM + 4 * lane + 256 * j)); } }
#pragma unroll
            for (int k = 0; k < 4; ++k) { const int rk = r + k * NGW; if (rk < SEQ) { unsigned char* hrow = H + (size_t)rk * DM;
#pragma unroll
                for (int j = 0; j < 8; ++j) { const f32x4 h = x[k][j] * s1[j] + t[j]; *(unsigned*)(hrow + 4 * lane + 256 * j) = pack4_fp8(h); } } }
        }
    }
    for (int r = SEQ + gw; r < MROWS; r += NGW) { f32x4 x[8];
#pragma unroll
        for (int j = 0; j < 8; ++j) x[j] = *(const f32x4*)(P.ctx + (size_t)(r - SEQ) * DM + 4 * lane + 256 * j);
        mod_row(x, MOD + (size_t)((0 * 2 + 1) * 3 + 0) * 2048, MOD + (size_t)((0 * 2 + 1) * 3 + 1) * 2048, (bf16_t*)(H + (size_t)r * DM), lane); }
}
__device__ __forceinline__ void ln_one(f32x4 (&v)[8]) {
    float s = 0.f;
#pragma unroll
    for (int j = 0; j < 8; ++j) s += (v[j][0] + v[j][1]) + (v[j][2] + v[j][3]);
    const float mean = wave_sum(s) * (1.f / DM); float q = 0.f;
#pragma unroll
    for (int j = 0; j < 8; ++j) { v[j] = v[j] - mean; q += (v[j][0] * v[j][0] + v[j][1] * v[j][1]) + (v[j][2] * v[j][2] + v[j][3] * v[j][3]); }
    const float rstd = 1.f / sqrtf(wave_sum(q) * (1.f / DM) + LN_EPS);
#pragma unroll
    for (int j = 0; j < 8; ++j) v[j] = v[j] * rstd;
}
__device__ __forceinline__ void phase_ln(const Params& P, int l) {
    const int lane = ltid() & 63, gw = lbid() * 8 + (ltid() >> 6), NGW = gridDim.x * 8;
    const float* MOD = (const float*)(lws(P.ws) + WS_MOD); unsigned char* H = lws(P.ws) + WS_H;   float* X = (float*)(lws(P.ws) + WS_X);
    const float* gam = P.ln_g + l * DM; const float* bet = P.ln_b + l * DM; const bool last = (l == 3);
    {
        const float* sh = MOD + (size_t)(((last ? l : l + 1) * 2 + 0) * 3 + 0) * 2048; const float* sc = sh + 2048;
        f32x4 ga[8], be[8], cur[8], nxt[8];
#pragma unroll
        for (int j = 0; j < 8; ++j) { const int col = 4 * lane + 256 * j; ga[j] = *(const f32x4*)(gam + col); be[j] = *(const f32x4*)(bet + col); }
        int r = gw;
        if (r < SEQ) {
#pragma unroll
            for (int j = 0; j < 8; ++j) cur[j] = *(const f32x4*)(X + (size_t)r * DM + 4 * lane + 256 * j); }
        for (; r < SEQ; r += NGW) { const int rn = r + NGW;
            if (rn < SEQ) {
#pragma unroll
                for (int j = 0; j < 8; ++j) nxt[j] = *(const f32x4*)(X + (size_t)rn * DM + 4 * lane + 256 * j); }
            ln_one(cur);
            float* dst = last ? P.out + (size_t)r * DM : X + (size_t)r * DM; bf16_t* hrow = (bf16_t*)(H + (size_t)r * DM);
#pragma unroll
            for (int j = 0; j < 8; ++j) { const int col = 4 * lane + 256 * j; const f32x4 y = cur[j] * ga[j] + be[j]; *(f32x4*)(dst + col) = y;
                if (!last) { const f32x4 h = y * (*(const f32x4*)(sc + col) + 1.f) + *(const f32x4*)(sh + col); *(unsigned*)((unsigned char*)hrow + col) = pack4_fp8(h); } }
#pragma unroll
            for (int j = 0; j < 8; ++j) cur[j] = nxt[j]; }
    }
    if (!last) for (int r = SEQ + gw; r < MROWS; r += NGW) {
        float* xr = X + (size_t)r * DM; f32x4 v[8]; const float* xsrc = l == 0 ? P.ctx + (size_t)(r - SEQ) * DM : xr;
        const float* part = (const float*)(lws(P.ws) + WS_S) + (size_t)(r - SEQ) * DM; const float* gtc = MOD + (size_t)((l * 2 + 1) * 3 + 2) * 2048;
#pragma unroll
        for (int j = 0; j < 8; ++j) { const int col = 4 * lane + 256 * j; f32x4 a = *(const f32x4*)(part + col);
#pragma unroll
            for (int ks = 1; ks < 4; ++ks) a += *(const f32x4*)(part + (size_t)ks * 256 * 2048 + col);
            v[j] = *(const f32x4*)(xsrc + col) * DN_ALPHA + *(const f32x4*)(gtc + col) * a; }
        ln_one(v);
#pragma unroll
        for (int j = 0; j < 8; ++j) { const int col = 4 * lane + 256 * j; v[j] = v[j] * *(const f32x4*)(gam + col) + *(const f32x4*)(bet + col); *(f32x4*)(xr + col) = v[j]; }
        mod_row(v, MOD + (size_t)(((l + 1) * 2 + 1) * 3 + 0) * 2048, MOD + (size_t)(((l + 1) * 2 + 1) * 3 + 1) * 2048, (bf16_t*)(H + (size_t)r * DM), lane); }
}
__device__ __forceinline__ bool odd_fix_ok(const Params& P, int i, int lane) {
    float mq = fmaxf(fabsf(P.q_norm_g[i * 128 + lane]), fabsf(P.q_norm_g[i * 128 + 64 + lane])), mk = fmaxf(fabsf(P.k_norm_g[i * 128 + lane]), fabsf(P.k_norm_g[i * 128 + 64 + lane]));
#pragma unroll
    for (int o = 1; o < 64; o <<= 1) { mq = fmaxf(mq, __shfl_xor(mq, o)); mk = fmaxf(mk, __shfl_xor(mk, o)); }
    return 11.313708498984761f * mq * mk * 1.02f * 1.4426950408889634f <= 64.f;
}
__device__ __forceinline__ void phase_qknorm(const Params& P, int i) {
    const int lane = ltid() & 63, gw = lbid() * 8 + (ltid() >> 6), NGW = gridDim.x * 8, c = lane & 7, hsub = lane >> 3;
    bf16_t* PB = (bf16_t*)(lws(P.ws) + WS_P);
    float gq1[8], gq2[8], gk1[8], gk2[8], inv[8]; const bool fixok = odd_fix_ok(P, i, lane);
#pragma unroll
    for (int e = 0; e < 8; ++e) { const int d = 8 * c + e; gq1[e] = P.q_norm_g[i * 128 + d]; gq2[e] = P.q_norm_g[i * 128 + 64 + d]; gk1[e] = P.k_norm_g[i * 128 + d]; gk2[e] = P.k_norm_g[i * 128 + 64 + d];
        inv[e] = exp2f(-(float)(d & 31) * (13.287712379549449f / 32.f)) * 0.15915494309189535f; }
    u32x4 av[3], bv[3], an[3], bn[3];
    if (gw < MROWS) {
#pragma unroll
        for (int ps = 0; ps < 3; ++ps) { const int hd = ps * 8 + hsub; if (hd < 20) { av[ps] = *(const u32x4*)(PB + (size_t)gw * LDO + hd * 128 + 8 * c); bv[ps] = *(const u32x4*)(PB + (size_t)gw * LDO + hd * 128 + 64 + 8 * c); } } }
    for (int r = gw; r < MROWS; r += NGW) {
        bf16_t* row = PB + (size_t)r * LDO;
        if (r + NGW < MROWS) { const bf16_t* rn = PB + (size_t)(r + NGW) * LDO;
#pragma unroll
            for (int ps = 0; ps < 3; ++ps) { const int hd = ps * 8 + hsub; if (hd < 20) { an[ps] = *(const u32x4*)(rn + hd * 128 + 8 * c); bn[ps] = *(const u32x4*)(rn + hd * 128 + 64 + 8 * c); } } }
        float cs[8], sn[8];
        if (r < SEQ) { const float pos = (float)(c < 4 ? (r >> 6) : (r & 63));
#pragma unroll
            for (int e = 0; e < 8; ++e) { float rev = pos * inv[e]; rev -= floorf(rev); cs[e] = __builtin_amdgcn_cosf(rev); sn[e] = __builtin_amdgcn_sinf(rev); } }
        else {
#pragma unroll
            for (int e = 0; e < 8; ++e) { cs[e] = 1.f; sn[e] = 0.f; } }
#pragma unroll
        for (int ps = 0; ps < 3; ++ps) { const int hd = ps * 8 + hsub; const bool act = hd < 20;
            float a[8], b[8]; float ss = 0.f;
#pragma unroll
            for (int e = 0; e < 4; ++e) { a[2 * e] = act ? bf_lo(av[ps][e]) : 0.f; a[2 * e + 1] = act ? bf_hi(av[ps][e]) : 0.f; b[2 * e] = act ? bf_lo(bv[ps][e]) : 0.f; b[2 * e + 1] = act ? bf_hi(bv[ps][e]) : 0.f; }
#pragma unroll
            for (int e = 0; e < 8; ++e) ss += a[e] * a[e] + b[e] * b[e];
            ss += __shfl_xor(ss, 1); ss += __shfl_xor(ss, 2); ss += __shfl_xor(ss, 4);
            const float rstd = 1.f / sqrtf(ss * (1.f / 128.f) + RMS_EPS); const bool isq = hd < 16;
            u32x4 oa, ob;
            const float rq = (isq && fixok) ? rstd * (att::SCALE * 1.4426950408889634f) : rstd;
#pragma unroll
            for (int e = 0; e < 4; ++e) { float x0 = a[2 * e] * rq * (isq ? gq1[2 * e] : gk1[2 * e]), x1 = a[2 * e + 1] * rq * (isq ? gq1[2 * e + 1] : gk1[2 * e + 1]);
                float y0 = b[2 * e] * rq * (isq ? gq2[2 * e] : gk2[2 * e]), y1 = b[2 * e + 1] * rq * (isq ? gq2[2 * e + 1] : gk2[2 * e + 1]);
                oa[e] = cvt_pk_bf16(x0 * cs[2 * e] - y0 * sn[2 * e], x1 * cs[2 * e + 1] - y1 * sn[2 * e + 1]);
                ob[e] = cvt_pk_bf16(y0 * cs[2 * e] + x0 * sn[2 * e], y1 * cs[2 * e + 1] + x1 * sn[2 * e + 1]); }
            if (act) { *(u32x4*)(row + hd * 128 + 8 * c) = oa; *(u32x4*)(row + hd * 128 + 64 + 8 * c) = ob; } }
#pragma unroll
        for (int ps = 0; ps < 3; ++ps) { av[ps] = an[ps]; bv[ps] = bn[ps]; }
    }
}

__device__ __forceinline__ void s5_stage_z(const bf16_t* __restrict__ PB, const bf16_t* __restrict__ HBg, unsigned char* ldsB, int g, int cb, int nks, int tid) {
    for (int piece = tid; piece < nks * 64; piece += 512) { const int ks = piece >> 6, ln = piece & 63, r32 = ln & 31, hi = ln >> 5; int bc = cb * 32 + r32; bc = bc < NCHUNK ? bc : NCHUNK - 1;
        const bf16_t* src = ks < 16 ? PB + (size_t)(bc * 16 + ks) * LDE + 4096 + g * 16 + hi * 8 : HBg + (size_t)bc * 256 + (ks - 16) * 16 + hi * 8;
        *(bf16x8*)(ldsB + piece * 16) = *(const bf16x8*)src; }
}
__device__ __forceinline__ void s5_gemm1_item(const bf16_t* __restrict__ PB, const bf16_t* __restrict__ T1g, float* __restrict__ Sg, unsigned char* ldsB, int g, int cb, int tid) {
    const int wid = tid >> 6, lane = tid & 63, r32 = lane & 31, hi = lane >> 5, bc = cb * 32 + r32;
    s5_stage_z(PB, nullptr, ldsB, g, cb, 16, tid);
    __syncthreads();
    f32x16 acc = {};
#pragma unroll
    for (int ks = 0; ks < 16; ++ks) { const bf16x8 a = *(const bf16x8*)(T1g + ((size_t)(wid * 16 + ks) * 64 + lane) * 8), b = *(const bf16x8*)(ldsB + (ks * 64 + lane) * 16); acc = __builtin_amdgcn_mfma_f32_32x32x16_bf16(a, b, acc, 0, 0, 0); }
    if (bc < NCHUNK) {
#pragma unroll
        for (int q = 0; q < 4; ++q) { const f32x4 v = {acc[4 * q], acc[4 * q + 1], acc[4 * q + 2], acc[4 * q + 3]}; *(f32x4*)(Sg + (size_t)bc * 256 + wid * 32 + 8 * q + 4 * hi) = v; } }
    __syncthreads();
}
__device__ __forceinline__ void s5_scan_item(const float* __restrict__ Sg, bf16_t* __restrict__ HBg, const float* __restrict__ LAMg, int dir, float* xl, int tid) {
    const int wid = tid >> 6, lane = tid & 63;
    const float lre = LAMg[(dir * 64 + lane) * 2], lim = LAMg[(dir * 64 + lane) * 2 + 1]; const int off = dir * 128 + lane;
#define S5_BC(n) (dir == 0 ? ((n) < 16 ? 512 + (n) : (n) - 16) : 527 - (n))
    const int n0 = wid * 66;
    float er = 0.f, ei = 0.f, pr = 1.f, pi = 0.f;
    for (int b = 0; b < 6; ++b) { float sr[11], si[11];
#pragma unroll
        for (int k = 0; k < 11; ++k) { const int bc = S5_BC(n0 + b * 11 + k); sr[k] = Sg[(size_t)bc * 256 + off]; si[k] = Sg[(size_t)bc * 256 + off + 64]; }
#pragma unroll
        for (int k = 0; k < 11; ++k) { const float tr = lre * er - lim * ei + sr[k], ti = lre * ei + lim * er + si[k]; er = tr; ei = ti; const float qr = pr * lre - pi * lim, qi = pr * lim + pi * lre; pr = qr; pi = qi; } }
    __syncthreads();
    xl[(wid * 64 + lane) * 2] = er; xl[(wid * 64 + lane) * 2 + 1] = ei;
    __syncthreads();
    float hr = 0.f, hi_ = 0.f;
    for (int w = 0; w < wid; ++w) { const float e0 = xl[(w * 64 + lane) * 2], e1 = xl[(w * 64 + lane) * 2 + 1]; const float tr = pr * hr - pi * hi_ + e0, ti = pr * hi_ + pi * hr + e1; hr = tr; hi_ = ti; }
    for (int b = 0; b < 6; ++b) { float sr[11], si[11];
#pragma unroll
        for (int k = 0; k < 11; ++k) { const int bc = S5_BC(n0 + b * 11 + k); sr[k] = Sg[(size_t)bc * 256 + off]; si[k] = Sg[(size_t)bc * 256 + off + 64]; }
#pragma unroll
        for (int k = 0; k < 11; ++k) { const int bc = S5_BC(n0 + b * 11 + k);
            HBg[(size_t)bc * 256 + off] = f2bf(hr); HBg[(size_t)bc * 256 + off + 64] = f2bf(hi_);
            const float tr = lre * hr - lim * hi_ + sr[k], ti = lre * hi_ + lim * hr + si[k]; hr = tr; hi_ = ti; } }
#undef S5_BC
    __syncthreads();
}
__device__ __forceinline__ void s5_gemm2_item(const bf16_t* __restrict__ PB, const bf16_t* __restrict__ T2g, const bf16_t* __restrict__ HBg, bf16_t* __restrict__ ZB, unsigned char* ldsB, int g, int cb, int tid) {
    const int wid = tid >> 6, lane = tid & 63, r32 = lane & 31, hi = lane >> 5, bc = cb * 32 + r32;
    s5_stage_z(PB, HBg, ldsB, g, cb, 32, tid);
    __syncthreads();
    f32x16 acc = {};
#pragma unroll
    for (int ks = 0; ks < 32; ++ks) { const bf16x8 a = *(const bf16x8*)(T2g + ((size_t)(wid * 32 + ks) * 64 + lane) * 8), b = *(const bf16x8*)(ldsB + (ks * 64 + lane) * 16); acc = __builtin_amdgcn_mfma_f32_32x32x16_bf16(a, b, acc, 0, 0, 0); }
    if (bc < NCHUNK) {
#pragma unroll
        for (int q = 0; q < 4; ++q) { const int t = 2 * wid + (q >> 1), co = (q & 1) * 8 + 4 * hi;
            u32x2 w; w.x = cvt_pk_bf16(gelu_tanh(acc[4 * q]), gelu_tanh(acc[4 * q + 1])); w.y = cvt_pk_bf16(gelu_tanh(acc[4 * q + 2]), gelu_tanh(acc[4 * q + 3]));
#ifdef EXP_ZERO_S5
            w.x = 0u; w.y = 0u;
#endif
            *(u32x2*)(ZB + (size_t)(bc * 16 + t) * 1024 + g * 16 + co) = w; } }
    __syncthreads();
}

template <int NKS>
__device__ __forceinline__ void s5_load_pieces(const bf16_t* __restrict__ PB, const bf16_t* __restrict__ HB, int it, int tid, bf16x8 (&pre)[NKS / 8]) {
    const int g = it / 17, cb = it % 17;
#pragma unroll
    for (int q = 0; q < NKS / 8; ++q) { const int piece = tid + 512 * q, ks = piece >> 6, ln = piece & 63, r32 = ln & 31, hi = ln >> 5; int bc = cb * 32 + r32; bc = bc < NCHUNK ? bc : NCHUNK - 1;
        const bf16_t* src = ks < 16 ? PB + (size_t)(bc * 16 + ks) * LDE + 4096 + g * 16 + hi * 8 : HB + (size_t)g * NCHUNK * 256 + (size_t)bc * 256 + (ks - 16) * 16 + hi * 8;
        pre[q] = *(const bf16x8*)src; }
}
template <int NKS>
__device__ __forceinline__ void s5_gemm_loop(const bf16_t* __restrict__ PB, const bf16_t* __restrict__ Tb, const bf16_t* __restrict__ HB, float* __restrict__ S, bf16_t* __restrict__ ZB, unsigned char* ldsB, int tid, int Gall, int b0) {
    const int wid = tid >> 6, lane = tid & 63, r32 = lane & 31, hi = lane >> 5; constexpr int NIT = 64 * 17; const int G = Gall - b0;
    bf16x8 pre[NKS / 8]; int it = lbid() >= b0 ? lbid() - b0 : NIT;
    if (it < NIT) s5_load_pieces<NKS>(PB, HB, it, tid, pre);
    for (; it < NIT; it += G) {
        const int g = it / 17, cb = it % 17, bc = cb * 32 + r32; const bf16_t* Tg = Tb + (size_t)g * (256 * NKS * 16);
#pragma unroll
        for (int q = 0; q < NKS / 8; ++q) *(bf16x8*)(ldsB + (tid + 512 * q) * 16) = pre[q];
        bf16x8 a[16];
#pragma unroll
        for (int ks = 0; ks < 16; ++ks) a[ks] = *(const bf16x8*)(Tg + ((size_t)(wid * NKS + ks) * 64 + lane) * 8);
        __syncthreads();
        if (it + G < NIT) s5_load_pieces<NKS>(PB, HB, it + G, tid, pre);
        f32x16 acc = {};
#pragma unroll
        for (int ks = 0; ks < 16; ++ks) acc = __builtin_amdgcn_mfma_f32_32x32x16_bf16(a[ks], *(const bf16x8*)(ldsB + (ks * 64 + lane) * 16), acc, 0, 0, 0);
        if constexpr (NKS == 32) {
#pragma unroll
            for (int ks = 0; ks < 16; ++ks) a[ks] = *(const bf16x8*)(Tg + ((size_t)(wid * NKS + 16 + ks) * 64 + lane) * 8);
#pragma unroll
            for (int ks = 0; ks < 16; ++ks) acc = __builtin_amdgcn_mfma_f32_32x32x16_bf16(a[ks], *(const bf16x8*)(ldsB + ((16 + ks) * 64 + lane) * 16), acc, 0, 0, 0);
        }
        if (bc < NCHUNK) {
            if constexpr (NKS == 16) {
#pragma unroll
                for (int q = 0; q < 4; ++q) { const f32x4 v = {acc[4 * q], acc[4 * q + 1], acc[4 * q + 2], acc[4 * q + 3]}; *(f32x4*)(S + (size_t)g * NCHUNK * 256 + (size_t)bc * 256 + wid * 32 + 8 * q + 4 * hi) = v; }
            } else {
#pragma unroll
                for (int q = 0; q < 4; ++q) { const int t = 2 * wid + (q >> 1), co = (q & 1) * 8 + 4 * hi;
                    u32x2 w; w.x = cvt_pk_bf16(gelu_tanh(acc[4 * q]), gelu_tanh(acc[4 * q + 1])); w.y = cvt_pk_bf16(gelu_tanh(acc[4 * q + 2]), gelu_tanh(acc[4 * q + 3]));
                    *(u32x2*)(ZB + (size_t)(bc * 16 + t) * 1024 + g * 16 + co) = w; }
            }
        }
        __syncthreads();
    }
}

__device__ __forceinline__ void phase_attn(const Params& P, int l, unsigned char* lds) {
    const int i = l >> 1; const bool even = (l & 1) == 0, need_ctx = l < 3; const int G = gridDim.x, tid = ltid(), wid = tid >> 6, lane = tid & 63;
    const bf16_t* PB = (const bf16_t*)(lws(P.ws) + WS_P); bf16_t* OG = (bf16_t*)(lws(P.ws) + WS_OG);
    const int ld = even ? LDE : LDO;
    const int nctx = even ? 8 : (need_ctx ? 16 : 0), nitems = even ? nctx : nctx + 512;
#ifndef NO_DENSE
    const float mfixC = 0.f; const bool fixok = !even && odd_fix_ok(P, i, lane);
    for (int it = lbid(); it < nitems; it += G) {
        int h, q0, base, NT;
        if (it < nctx) { h = it; q0 = SEQ; base = SEQ; NT = 4; } else { const int r = it - nctx; h = r >> 5; q0 = (r & 31) * 256; base = 0; NT = MROWS / 64; }
        const int kcol = even ? 1024 + h * 128 : 2048 + (h >> 2) * 128, vcol = even ? 2048 + h * 128 : 2560 + (h >> 2) * 128;
        if (even) att::attn_body<LDE, att::DenseTiles, false>(PB + (size_t)q0 * ld + h * 128, PB + kcol, PB + vcol, PB + (size_t)q0 * ld + 3072 + h * 128, (bf16_t*)((unsigned char*)OG + (size_t)q0 * 2048 + h * 128), NT, att::DenseTiles{base}, (char*)lds, mfixC);
        else if (fixok) att::attn_body<LDO, att::DenseTiles, true>(PB + (size_t)q0 * ld + h * 128, PB + kcol, PB + vcol, PB + (size_t)q0 * ld + 3072 + h * 128, (bf16_t*)((unsigned char*)OG + (size_t)q0 * 2048 + h * 128), NT, att::DenseTiles{base}, (char*)lds, mfixC);
        else att::attn_body<LDO, att::DenseTiles, false>(PB + (size_t)q0 * ld + h * 128, PB + kcol, PB + vcol, PB + (size_t)q0 * ld + 3072 + h * 128, (bf16_t*)((unsigned char*)OG + (size_t)q0 * 2048 + h * 128), NT, att::DenseTiles{base}, (char*)lds, mfixC);
    }
#endif
    if (even) {
        float* rpbS = (float*)(lds + 8 * 16640);
#ifndef NO_NA
        for (int it = lbid(); it < 256; it += G) {
            const int h = it & 7, rb = it >> 3;
            __syncthreads();
            for (int e = tid; e < 465; e += 512) rpbS[e] = P.na_rpb[(size_t)(i * 8 + h) * 465 + e] * (1.f / att::SCALE);
            __syncthreads();
            att::na_wave(PB, OG, rpbS, rb * 4 + (wid >> 1), (wid & 1) * 32, h, (char*)lds + wid * 16640, lane);
        }
        __syncthreads();
#endif
        const bf16_t* T1 = (const bf16_t*)(lws(P.ws) + WS_T1) + (size_t)i * 64 * 256 * 256; float* S = (float*)(lws(P.ws) + WS_S);
        s5_gemm_loop<16>(PB, T1, nullptr, S, nullptr, lds, tid, G, 8);
    }
}

__device__ __forceinline__ void decode_phase(int ph, int& kind, int& l) {
    l = 0;
    if (ph < 3) { kind = ph; return; }
    int r = ph - 3; if (r >= 7) { r -= 7; l = 1; if (r >= 5) { r -= 5; l = 2; if (r >= 7) { r -= 7; l = 3; } } }
    if ((l & 1) == 0) kind = 3 + r; else kind = (r == 0) ? 3 : (r == 1) ? 10 : (r == 2) ? 4 : (r == 3) ? 8 : 9;
}
__device__ __forceinline__ void run_kind(const Params& P, int kind, int l, unsigned char* lds) {
    LAS unsigned char* ldsl = (LAS unsigned char*)lds;
    unsigned char* ws = lws(P.ws); const int G = gridDim.x;
    const int i = l >> 1; const bool even = (l & 1) == 0;
#ifndef PHMASK
#define PHMASK 0xffff
#endif
    if (!((PHMASK >> kind) & 1)) return;
    switch (kind) {
    case 0: phase_prologue(P, ldsl); break;
    case 1: phase_finalize_mod(P); break;
    case 2: phase_mod0(P); break;
    case 3: {
        const int N = even ? EVEN_IN : ODD_IN; const bf16_t* Bt = even ? (const bf16_t*)(ws + WS_WEVIN + (size_t)i * 6144 * 2048) : (const bf16_t*)(ws + WS_WODIN + (size_t)i * 5120 * 2048);
        pg8::Gemm g{(const bf16_t*)(ws + WS_H), Bt, MROWS, N, DM / 2, DM / 2}; pg8::StaticOrder S; S.init(MROWS, N, G, (int)lbid());
        pg8::EpiBf16 E{(bf16_t*)(ws + WS_P), even ? LDE : LDO, 1.f / WIN_SCALE};
        pg8::gemm_phase<pg8::EpiBf16, pg8::StaticOrder, true, true, true>(ldsl, g, S, E);
    } break;
    case 4: phase_attn(P, l, lds); break;
    case 5: {
        for (int it = lbid(); it < 128; it += G) { const int g = it >> 1, dir = it & 1;
            s5_scan_item((const float*)(ws + WS_S) + (size_t)g * NCHUNK * 256, (bf16_t*)(ws + WS_HB) + (size_t)g * NCHUNK * 256, (const float*)(ws + WS_LAM) + (size_t)(i * 64 + g) * 256, dir, (float*)lds, ltid()); }
    } break;
    case 6: {
        const bf16_t* T2 = (const bf16_t*)(ws + WS_T2) + (size_t)i * 64 * 256 * 512;
        s5_gemm_loop<32>((const bf16_t*)(ws + WS_P), T2, (const bf16_t*)(ws + WS_HB), nullptr, (bf16_t*)(ws + WS_ZB), lds, ltid(), G, 0);
    } break;
    case 7: {
        pg8::Gemm g{(const bf16_t*)(ws + WS_ZB), (const bf16_t*)(ws + WS_WGLU) + (size_t)i * 1024 * 1024, MROWS, 1024, 1024, 1024}; pg8::StaticOrder S; S.init(MROWS, 1024, G, (int)lbid());
        pg8::EpiGlu E{(const bf16_t*)(ws + WS_ZB), (const bf16_t*)(ws + WS_P), P.s5_glu_b + i * 1024, (bf16_t*)(ws + WS_OG)};
        pg8::gemm_phase<pg8::EpiGlu, pg8::StaticOrder, true, true>(ldsl, g, S, E);
    } break;
    case 8: {
        const bf16_t* Bt = even ? (const bf16_t*)(ws + WS_WEVOUT + (size_t)i * 2048 * 2048) : (const bf16_t*)(ws + WS_WODOUT + (size_t)i * 2048 * 2048);
        {   pg8::Gemm g{(const bf16_t*)(ws + WS_OG), Bt, SEQ, DM, DM / 2, DM / 2}; pg8::StaticOrder S; S.init(SEQ, DM, G, (int)lbid());
            float* X = (float*)(ws + WS_X); const float* MOD = (const float*)(ws + WS_MOD);
            pg8::EpiOut E{l == 0 ? P.x : X, X, X, MOD + (size_t)((l * 2 + 0) * 3 + 2) * 2048, MOD + (size_t)((l * 2 + 0) * 3 + 2) * 2048, DN_ALPHA, 1.f / (OG_SCALE * WOUT_SCALE)};
            pg8::gemm_phase<pg8::EpiOut, pg8::StaticOrder, true, true, true>(ldsl, g, S, E); }
    } break;
    case 9: phase_ln(P, l); break;
    case 10: phase_qknorm(P, i); break;
    case 11: {
        const unsigned char* Bt = even ? ws + WS_WEVOUT + (size_t)i * 2048 * 2048 : ws + WS_WODOUT + (size_t)i * 2048 * 2048;
        const int b = lbid(), ks = b >> 3;
        pg8::Gemm g{(const bf16_t*)(ws + WS_OG + (size_t)SEQ * DM + ks * 512), (const bf16_t*)(Bt + ks * 512), 256, DM, 256, DM / 2}; pg8::OneUnit S{b & 7, b < 32};
        pg8::EpiPart E{(float*)(ws + WS_S) + (size_t)ks * 256 * 2048, 1.f / (OG_SCALE * WOUT_SCALE)};
        pg8::gemm_phase<pg8::EpiPart, pg8::OneUnit, false, true, true>(ldsl, g, S, E);
    } break;
    case 12: case 13: case 14: case 15: {
        const int b0 = kind == 12 ? 24 : kind == 13 ? 132 : kind == 14 ? 148 : 24;
        if (lbid() >= b0) convert_seg(P, kind - 11, (lbid() - b0) * 8 + (ltid() >> 6), (G - b0) * 8, (LAS float*)(ldsl + (ltid() >> 6) * 16640), ltid() & 63);
    } break;
    default: break;
    }
}

#define RLX_AGENT __ATOMIC_RELAXED, __HIP_MEMORY_SCOPE_AGENT
#define XB_TMO      128
#define XB_XCNT(j)  (256  + 64 * (j))
#define XB_XSUB(j)  (1280 + 64 * (j))
#define XB_XGEN(j)  (2304 + 64 * (j))
#define XB_TOP      3328
#define XB_TOPGEN   3392
#define XCD_BAR_WORDS 3456
#define XB_SPIN_CAP (1u << 18)

__device__ __forceinline__ unsigned xb_ld(unsigned* p)              { return __hip_atomic_load(p, __ATOMIC_RELAXED, __HIP_MEMORY_SCOPE_AGENT); }
__device__ __forceinline__ unsigned xb_add(unsigned* p, unsigned v) { return __hip_atomic_fetch_add(p, v, __ATOMIC_RELAXED, __HIP_MEMORY_SCOPE_AGENT); }
__device__ __forceinline__ unsigned xb_xcc_id() { return (unsigned)__builtin_amdgcn_s_getreg((3 << 11) | 20) & 0xFu; }
#define XB_SPIN(cond, bar) do { unsigned _sp = 0; while (cond) { __builtin_amdgcn_s_sleep(1); \
    if ((++_sp & 255u) == 0u) { if (xb_ld(&(bar)[XB_TMO])) break; if (_sp > XB_SPIN_CAP) { atomicAdd(&(bar)[XB_TMO], 1u); break; } } } } while (0)

struct XcdBarrier {
    unsigned* bar; unsigned x;
    volatile LAS unsigned* st;
};

__device__ __forceinline__ XcdBarrier xcd_barrier_post(unsigned* bar, volatile LAS unsigned* st) {
    XcdBarrier b; b.bar = bar; b.x = xb_xcc_id(); b.st = st;
    if (ltid() == 0) (void)xb_add(&bar[XB_XCNT(b.x)], 1u);
    return b;
}
__device__ __forceinline__ void xcd_barrier_complete(unsigned* bar, unsigned x, unsigned& nloc, unsigned& nx) {
    const unsigned G = gridDim.x * gridDim.y * gridDim.z;
    unsigned sum, cnt, mine, sp = 0u;
    for (;;) {
        sum = 0u; cnt = 0u; mine = 0u;
#pragma unroll
        for (unsigned j = 0; j < 16; ++j) { const unsigned c = xb_ld(&bar[XB_XCNT(j)]); sum += c; cnt += (c > 0u) ? 1u : 0u; mine = (j == x) ? c : mine; }
        if (sum == G) break;
        __builtin_amdgcn_s_sleep(1);
        if ((++sp & 255u) == 0u) { if (xb_ld(&bar[XB_TMO])) break; if (sp > XB_SPIN_CAP) { atomicAdd(&bar[XB_TMO], 1u); break; } }
    }
    nloc = mine > 0u ? mine : 1u; nx = cnt > 0u ? cnt : 1u;
}

__device__ __forceinline__ void xcd_barrier(const XcdBarrier& b) {
    asm volatile("s_waitcnt vmcnt(0)" ::: "memory");
    __syncthreads();
    if (ltid() == 0) {
        unsigned* bar = b.bar;
        __builtin_amdgcn_s_waitcnt(0);
        unsigned nloc = b.st[0], nx = b.st[1];
        if (nloc == 0u) { xcd_barrier_complete(bar, b.x, nloc, nx); b.st[0] = nloc; b.st[1] = nx; }
        const unsigned old = xb_add(&bar[XB_XSUB(b.x)], 1u);
        const unsigned gen = old / nloc;
        if (old + 1u == (gen + 1u) * nloc) {
            __builtin_amdgcn_fence(__ATOMIC_RELEASE, "agent");
            asm volatile("s_waitcnt vmcnt(0)" ::: "memory");
            const unsigned og = xb_add(&bar[XB_TOP], 1u);
            const unsigned tg = og / nx;
            if (og + 1u == (tg + 1u) * nx) xb_add(&bar[XB_TOPGEN], 1u);
            else XB_SPIN(xb_ld(&bar[XB_TOPGEN]) == tg, bar);
            __builtin_amdgcn_fence(__ATOMIC_ACQUIRE, "agent");
            xb_add(&bar[XB_XGEN(b.x)], 1u);
            asm volatile("s_waitcnt vmcnt(0)" ::: "memory");
        } else {
            XB_SPIN(xb_ld(&bar[XB_XGEN(b.x)]) == gen, bar);
            __builtin_amdgcn_fence(__ATOMIC_ACQUIRE, "agent");
            asm volatile("s_waitcnt vmcnt(0)" ::: "memory");
        }
    }
    __syncthreads();
}

__global__ void __launch_bounds__(512, 2) mega_fwd(Params P) {
    extern __shared__ __attribute__((aligned(16))) unsigned char lds[];
    cg::grid_group grid = cg::this_grid();
    volatile LAS unsigned* misc = (volatile LAS unsigned*)((LAS unsigned char*)lds + LDS_BYTES - 64);
    if (threadIdx.x < 16) misc[threadIdx.x] = 0u;
    __syncthreads();
    XcdBarrier bar = xcd_barrier_post((unsigned*)P.ws, misc);
#define GRID_BAR(ph) do { if ((ph) == P.ph_lo) grid.sync(); else xcd_barrier(bar); } while (0)
    for (int ph = P.ph_lo; ph < P.ph_hi; ++ph) {
        int kind, l; decode_phase(ph, kind, l);
        const int kind2 = (kind == 8 && l < 3) ? 11 : (kind == 3 && l == 0) ? 12 : (kind == 7 && l == 0) ? 13 : (kind == 3 && l == 1) ? 14 : (kind == 3 && l == 2) ? 15 : -1;
        const int nsub = kind2 >= 0 ? 2 : 1;
        for (int sub = 0; sub < nsub; ++sub) run_kind(P, sub == 0 ? kind : kind2, l, lds);
        if (ph + 1 < P.ph_hi) GRID_BAR(ph);
    }
}

#ifndef MK_SPLIT
#define MK_SPLIT 0
#endif
extern "C" void kernel_launch(void* const* d_in, const int* in_sizes, int n_in, void* d_out, int out_size, void* d_ws, size_t ws_size, hipStream_t stream) {
    static int grid = 0;
    if (grid == 0) {
        if (n_in != 25 || out_size != SEQ * DM || ws_size < WS_END) { fprintf(stderr, "kernel_launch: unexpected shapes (n_in %d out %d ws %zu)\n", n_in, out_size, ws_size); grid = -1; return; }
        int dev = 0, cus = 0, per_cu = 0;
        hipGetDevice(&dev); hipDeviceGetAttribute(&cus, hipDeviceAttributeMultiprocessorCount, dev);
        if (hipFuncSetAttribute((const void*)mega_fwd, hipFuncAttributeMaxDynamicSharedMemorySize, LDS_BYTES) != hipSuccess) { fprintf(stderr, "kernel_launch: hipFuncSetAttribute failed\n"); grid = -1; return; }
        if (hipOccupancyMaxActiveBlocksPerMultiprocessor(&per_cu, (const void*)mega_fwd, 512, LDS_BYTES) != hipSuccess || per_cu < 1) { fprintf(stderr, "kernel_launch: occupancy query says %d\n", per_cu); grid = -1; return; }
        grid = cus;
        fprintf(stderr, "kernel_launch: grid %d (per_cu %d)\n", grid, per_cu);
    }
    if (grid < 0) return;
    if (hipMemsetAsync(d_ws, 0, 16384, stream) != hipSuccess) { fprintf(stderr, "kernel_launch: memset failed\n"); return; }
    Params p{};
    const float** pp = (const float**)&p;
    for (int k = 0; k < 25; ++k) pp[k] = (const float*)d_in[k];
    p.out = (float*)d_out; p.ws = (unsigned char*)d_ws;
#if MK_SPLIT
    for (int ph = 0; ph < NPH; ++ph) { p.ph_lo = ph; p.ph_hi = ph + 1; void* args[] = {&p};
        hipError_t e = hipLaunchCooperativeKernel((void*)mega_fwd, dim3(grid), dim3(512), args, LDS_BYTES, stream);
        if (e != hipSuccess) { fprintf(stderr, "launch %d failed: %s\n", ph, hipGetErrorString(e)); break; } }
#else
    p.ph_lo = 0; p.ph_hi = NPH; void* args[] = {&p};
    hipError_t e = hipLaunchCooperativeKernel((void*)mega_fwd, dim3(grid), dim3(512), args, LDS_BYTES, stream);
    if (e != hipSuccess) fprintf(stderr, "cooperative launch failed: %s (grid %d)\n", hipGetErrorString(e), grid);
#endif
}
```
